# Optimizing an MI355X kernel written in HIP

```python
import jax
import jax.numpy as jnp
from jax import lax
import numpy as np


D_MODEL = 2048
BATCH = 8
SEQ = 2048
DEPTH = 4

A_HEADS = 8
A_HEAD_DIM = 128
A_WIDTH = A_HEADS * A_HEAD_DIM
MOBA_BLOCK = 256
MOBA_TOPK = 3
MOBA_Q_CHUNK = 8
B_HEADS = 16
B_HEAD_DIM = 64
B_WIDTH = B_HEADS * B_HEAD_DIM
LORA_W = 64
LORA_A = 64
LORA_G = 160
LORA_V = 32
C_WIDTH = D_MODEL
CONV_WIDTH = 3
D_FF = 5632
RMS_EPS = 1e-6
GN_EPS = 64e-5
NEG_INF = -1e30

kernel_name = 'moba_rwkv7_shortconv_hybrid'


def rms_norm(x, gain):
    xf = x.astype(jnp.float32)
    y = xf * lax.rsqrt(jnp.mean(xf * xf, axis=-1, keepdims=True) + RMS_EPS)
    return y.astype(x.dtype) * gain


def causal_dwconv(u, w):
    seq = u.shape[1]
    u_pad = jnp.pad(u, ((0, 0), (CONV_WIDTH - 1, 0), (0, 0)))
    out = w[0] * u_pad[:, :seq]
    for j in range(1, CONV_WIDTH):
        out = out + w[j] * u_pad[:, j:j + seq]
    return out


def alibi_slopes(n_heads):
    return jnp.exp2(-8.0 * jnp.arange(1, n_heads + 1, dtype=jnp.float32) / n_heads)


def moba_attention(q, k, v, q_gain, k_gain):
    bsz, seq, nh, hd = q.shape
    qn = rms_norm(q, q_gain).astype(jnp.float32).transpose(0, 2, 1, 3)
    kn = rms_norm(k, k_gain).astype(jnp.float32).transpose(0, 2, 1, 3)
    vh = v.astype(jnp.float32).transpose(0, 2, 1, 3)
    nb = -(-seq // MOBA_BLOCK)
    pad = nb * MOBA_BLOCK - seq
    kb = jnp.pad(kn, ((0, 0), (0, 0), (0, pad), (0, 0))).reshape(bsz, nh, nb, MOBA_BLOCK, hd)
    vb = jnp.pad(vh, ((0, 0), (0, 0), (0, pad), (0, 0))).reshape(bsz, nh, nb, MOBA_BLOCK, hd)
    k_mean = jnp.mean(kb, axis=3)
    n_sel = min(MOBA_TOPK, nb)
    slopes = alibi_slopes(nh)
    scale = hd ** -0.5
    b_ix = jnp.arange(bsz)[:, None, None, None]
    h_ix = jnp.arange(nh)[None, :, None, None]
    key_off = jnp.arange(MOBA_BLOCK)
    blk_ids = jnp.arange(nb)

    def chunk(c):
        t0 = c * MOBA_Q_CHUNK
        blk = t0 // MOBA_BLOCK
        qc = lax.dynamic_slice_in_dim(qn, t0, MOBA_Q_CHUNK, axis=2)
        t_pos = t0 + jnp.arange(MOBA_Q_CHUNK)
        gate = jnp.einsum('bhqd,bhnd->bhqn', qc, k_mean)
        gate = jnp.where(blk_ids < blk, gate, NEG_INF)
        _, sel = lax.top_k(gate, n_sel)
        valid = sel < blk
        k_sel = kb[b_ix, h_ix, sel]
        v_sel = vb[b_ix, h_ix, sel]
        s_past = jnp.einsum('bhqd,bhqjsd->bhqjs', qc, k_sel) * scale
        dist_past = (t_pos[:, None, None] - (sel[..., None] * MOBA_BLOCK + key_off)).astype(jnp.float32)
        s_past = jnp.where(valid[..., None], s_past - slopes[:, None, None, None] * dist_past, NEG_INF)
        k_own = lax.dynamic_index_in_dim(kb, blk, axis=2, keepdims=False)
        v_own = lax.dynamic_index_in_dim(vb, blk, axis=2, keepdims=False)
        s_own = jnp.einsum('bhqd,bhsd->bhqs', qc, k_own) * scale
        dist_own = (t_pos[:, None] - (blk * MOBA_BLOCK + key_off)[None, :]).astype(jnp.float32)
        s_own = jnp.where(dist_own >= 0, s_own - slopes[:, None, None] * dist_own, NEG_INF)
        scores = jnp.concatenate([s_past.reshape(bsz, nh, MOBA_Q_CHUNK, n_sel * MOBA_BLOCK), s_own], axis=-1)
        probs = jax.nn.softmax(scores, axis=-1)
        p_past = probs[..., :n_sel * MOBA_BLOCK].reshape(bsz, nh, MOBA_Q_CHUNK, n_sel, MOBA_BLOCK)
        p_own = probs[..., n_sel * MOBA_BLOCK:]
        return (jnp.einsum('bhqjs,bhqjsd->bhqd', p_past, v_sel)
                + jnp.einsum('bhqs,bhsd->bhqd', p_own, v_own))

    out = lax.map(chunk, jnp.arange(seq // MOBA_Q_CHUNK))
    out = out.transpose(1, 0, 3, 2, 4).reshape(bsz, seq, nh * hd)
    return out.astype(q.dtype)


def rwkv7_step(state, inp):
    r, w, k, v, a, b = inp
    sa = jnp.einsum('bhvk,bhk->bhv', state, a)
    state = state * w[:, :, None, :] + sa[..., None] * b[:, :, None, :] + v[..., None] * k[:, :, None, :]
    y = jnp.einsum('bhvk,bhk->bhv', state, r)
    return state, y


def rwkv7_time_mix(p, shift_mu, w0, w_lora, a0, a_lora, g_lora, k_k, k_a, r_k, gn_w, gn_b,
                   v0, v_lora, v_first):
    bsz, seq, _ = p.shape
    p_prev = jnp.pad(p, ((0, 0), (1, 0), (0, 0)))[:, :seq]
    p = p + shift_mu * (p_prev - p)
    r = p[..., :B_WIDTH]
    k = p[..., B_WIDTH:2 * B_WIDTH]
    v = p[..., 2 * B_WIDTH:3 * B_WIDTH]
    o = 3 * B_WIDTH
    z_w = p[..., o:o + LORA_W]
    o = o + LORA_W
    z_a = p[..., o:o + LORA_A]
    o = o + LORA_A
    z_g = p[..., o:o + LORA_G]
    o = o + LORA_G
    w = -jax.nn.softplus(-(w0 + jnp.tanh(z_w) @ w_lora)) - 0.5
    a = jax.nn.sigmoid(a0 + z_a @ a_lora)
    g = jax.nn.sigmoid(z_g) @ g_lora
    if v_lora is None:
        v_first = v
    else:
        z_v = p[..., o:o + LORA_V]
        v = v + (v_first - v) * jax.nn.sigmoid(v0 + z_v @ v_lora)

    def heads(t):
        return t.reshape(bsz, seq, B_HEADS, B_HEAD_DIM).astype(jnp.float32)

    kk = heads(k * k_k)
    kk = kk / jnp.maximum(jnp.sqrt(jnp.sum(kk * kk, axis=-1, keepdims=True)), 1e-12)
    k = k * (1.0 + (a - 1.0) * k_a)
    rh, kh, vh, ah = heads(r), heads(k), heads(v), heads(a)
    decay = jnp.exp(-jnp.exp(heads(w)))
    xs = tuple(jnp.moveaxis(t, 1, 0) for t in (rh, decay, kh, vh, -kk, kk * ah))
    state0 = jnp.zeros((bsz, B_HEADS, B_HEAD_DIM, B_HEAD_DIM), jnp.float32)
    _, y = lax.scan(rwkv7_step, state0, xs)
    y = jnp.moveaxis(y, 0, 1)
    mean = jnp.mean(y, axis=-1, keepdims=True)
    var = jnp.mean(jnp.square(y - mean), axis=-1, keepdims=True)
    y = ((y - mean) * lax.rsqrt(var + GN_EPS)).reshape(bsz, seq, B_WIDTH) * gn_w + gn_b
    bonus = jnp.sum(rh * kh * r_k, axis=-1, keepdims=True) * vh
    y = (y + bonus.reshape(bsz, seq, B_WIDTH)) * g
    return y.astype(p.dtype), v_first


def moba_rwkv_layer(x, norm_mix, w_in, q_gain, k_gain, shift_mu, w0, w_lora, a0, a_lora, g_lora,
                    k_k, k_a, r_k, gn_w, gn_b, w_out, v0, v_lora, v_first):
    bsz, seq, _ = x.shape
    proj = rms_norm(x, norm_mix) @ w_in
    qkv = proj[..., :3 * A_WIDTH].reshape(bsz, seq, 3, A_HEADS, A_HEAD_DIM)
    y_a = moba_attention(qkv[:, :, 0], qkv[:, :, 1], qkv[:, :, 2], q_gain, k_gain)
    y_b, v_first = rwkv7_time_mix(proj[..., 3 * A_WIDTH:], shift_mu, w0, w_lora, a0, a_lora, g_lora,
                                  k_k, k_a, r_k, gn_w, gn_b, v0, v_lora, v_first)
    y = jnp.concatenate([y_a, y_b], axis=-1) @ w_out
    return x + y, v_first


def short_conv_layer(x, norm_mix, conv_in, conv_w, conv_out):
    h = rms_norm(x, norm_mix) @ conv_in
    gate_b, gate_c, u = jnp.split(h, 3, axis=-1)
    return x + (gate_b * causal_dwconv(gate_c * u, conv_w)) @ conv_out


def conv_ffn(x, norm_ffn, ffn_up, ffn_conv, ffn_down):
    h = causal_dwconv(rms_norm(x, norm_ffn) @ ffn_up, ffn_conv)
    gate, val = jnp.split(h, 2, axis=-1)
    return x + (jax.nn.silu(gate) * val) @ ffn_down


def setup_inputs(seed: int = 0) -> dict:
    key = jax.random.key(seed)
    keys = list(jax.random.split(key, 128))

    def nrm(shape, scale):
        return scale * jax.random.normal(keys.pop(), shape, jnp.float32)

    def gain(shape):
        return 1.0 + nrm(shape, 0.02)

    def unif(shape, lo, hi):
        return jax.random.uniform(keys.pop(), shape, jnp.float32, lo, hi)

    inputs = {'x': nrm((BATCH, SEQ, D_MODEL), 1.0)}
    for li in range(DEPTH):
        p = 'l%d_' % li
        inputs[p + 'norm_mix'] = gain((D_MODEL,))
        if li % 2 == 0:
            first = li == 0
            lora_cols = LORA_W + LORA_A + LORA_G + (0 if first else LORA_V)
            rwkv_cols = 3 * B_WIDTH + lora_cols
            inputs[p + 'w_in'] = nrm((D_MODEL, 3 * A_WIDTH + rwkv_cols), D_MODEL ** -0.5)
            inputs[p + 'q_gain'] = gain((A_HEAD_DIM,))
            inputs[p + 'k_gain'] = gain((A_HEAD_DIM,))
            inputs[p + 'shift_mu'] = unif((rwkv_cols,), 0.2, 0.8)
            inputs[p + 'w0'] = unif((B_WIDTH,), -6.0, -1.0)
            inputs[p + 'w_lora'] = nrm((LORA_W, B_WIDTH), 0.5 * LORA_W ** -0.5)
            inputs[p + 'a0'] = nrm((B_WIDTH,), 0.1)
            inputs[p + 'a_lora'] = nrm((LORA_A, B_WIDTH), LORA_A ** -0.5)
            inputs[p + 'g_lora'] = nrm((LORA_G, B_WIDTH), LORA_G ** -0.5)
            inputs[p + 'k_k'] = 0.85 + nrm((B_WIDTH,), 0.05)
            inputs[p + 'k_a'] = 1.0 + nrm((B_WIDTH,), 0.05)
            inputs[p + 'r_k'] = nrm((B_HEADS, B_HEAD_DIM), 0.1)
            inputs[p + 'gn_w'] = gain((B_WIDTH,))
            inputs[p + 'gn_b'] = nrm((B_WIDTH,), 0.02)
            inputs[p + 'w_out'] = nrm((A_WIDTH + B_WIDTH, D_MODEL), (A_WIDTH + B_WIDTH) ** -0.5)
            if not first:
                inputs[p + 'v0'] = nrm((B_WIDTH,), 0.1)
                inputs[p + 'v_lora'] = nrm((LORA_V, B_WIDTH), LORA_V ** -0.5)
        else:
            inputs[p + 'conv_in'] = nrm((D_MODEL, 3 * C_WIDTH), D_MODEL ** -0.5)
            inputs[p + 'conv_w'] = nrm((CONV_WIDTH, C_WIDTH), 0.5)
            inputs[p + 'conv_out'] = nrm((C_WIDTH, D_MODEL), C_WIDTH ** -0.5)
        inputs[p + 'norm_ffn'] = gain((D_MODEL,))
        inputs[p + 'ffn_up'] = nrm((D_MODEL, 2 * D_FF), D_MODEL ** -0.5)
        inputs[p + 'ffn_conv'] = nrm((CONV_WIDTH, 2 * D_FF), 0.5)
        inputs[p + 'ffn_down'] = nrm((D_FF, D_MODEL), D_FF ** -0.5)
    return inputs


def reference(x,
              l0_norm_mix, l0_w_in, l0_q_gain, l0_k_gain, l0_shift_mu, l0_w0, l0_w_lora, l0_a0,
              l0_a_lora, l0_g_lora, l0_k_k, l0_k_a, l0_r_k, l0_gn_w, l0_gn_b, l0_w_out,
              l0_norm_ffn, l0_ffn_up, l0_ffn_conv, l0_ffn_down,
              l1_norm_mix, l1_conv_in, l1_conv_w, l1_conv_out,
              l1_norm_ffn, l1_ffn_up, l1_ffn_conv, l1_ffn_down,
              l2_norm_mix, l2_w_in, l2_q_gain, l2_k_gain, l2_shift_mu, l2_w0, l2_w_lora, l2_a0,
              l2_a_lora, l2_g_lora, l2_k_k, l2_k_a, l2_r_k, l2_gn_w, l2_gn_b, l2_w_out,
              l2_v0, l2_v_lora,
              l2_norm_ffn, l2_ffn_up, l2_ffn_conv, l2_ffn_down,
              l3_norm_mix, l3_conv_in, l3_conv_w, l3_conv_out,
              l3_norm_ffn, l3_ffn_up, l3_ffn_conv, l3_ffn_down):
    mix_layers = (
        (l0_norm_mix, l0_w_in, l0_q_gain, l0_k_gain, l0_shift_mu, l0_w0, l0_w_lora, l0_a0,
         l0_a_lora, l0_g_lora, l0_k_k, l0_k_a, l0_r_k, l0_gn_w, l0_gn_b, l0_w_out, None, None),
        (l1_norm_mix, l1_conv_in, l1_conv_w, l1_conv_out),
        (l2_norm_mix, l2_w_in, l2_q_gain, l2_k_gain, l2_shift_mu, l2_w0, l2_w_lora, l2_a0,
         l2_a_lora, l2_g_lora, l2_k_k, l2_k_a, l2_r_k, l2_gn_w, l2_gn_b, l2_w_out, l2_v0, l2_v_lora),
        (l3_norm_mix, l3_conv_in, l3_conv_w, l3_conv_out),
    )
    ffn_layers = (
        (l0_norm_ffn, l0_ffn_up, l0_ffn_conv, l0_ffn_down),
        (l1_norm_ffn, l1_ffn_up, l1_ffn_conv, l1_ffn_down),
        (l2_norm_ffn, l2_ffn_up, l2_ffn_conv, l2_ffn_down),
        (l3_norm_ffn, l3_ffn_up, l3_ffn_conv, l3_ffn_down),
    )
    v_first = None
    for li in range(DEPTH):
        if li % 2 == 0:
            x, v_first = moba_rwkv_layer(x, *mix_layers[li], v_first)
        else:
            x = short_conv_layer(x, *mix_layers[li])
        x = conv_ffn(x, *ffn_layers[li])
    return x
```

```cpp
#include <hip/hip_runtime.h>
#include <cstdio>
#include <cstdint>
__device__ __forceinline__ int lane_id_opaque() { int l; asm volatile("v_mbcnt_lo_u32_b32 %0, -1, 0\n\tv_mbcnt_hi_u32_b32 %0, -1, %0" : "=v"(l)); return l; }
__device__ __forceinline__ int opq_s(int x) { asm volatile("" : "+s"(x)); return x; }
template <int CTRL> __device__ __forceinline__ float dppx(float x) { return __builtin_bit_cast(float, __builtin_amdgcn_mov_dpp(__builtin_bit_cast(int, x), CTRL, 0xf, 0xf, true)); }
__device__ __forceinline__ float xlane16(float x) { return __builtin_bit_cast(float, __builtin_amdgcn_ds_swizzle(__builtin_bit_cast(int, x), 0x401F)); }
__device__ __forceinline__ float sum_x32(float x) { auto rr = __builtin_amdgcn_permlane32_swap(__float_as_uint(x), __float_as_uint(x), false, false); return __uint_as_float(rr[0]) + __uint_as_float(rr[1]); }
__device__ __forceinline__ float xsum_rows4(float x) { x += xlane16(x); return sum_x32(x); }
__device__ __forceinline__ float asum16(float x) { x += dppx<0xB1>(x); x += dppx<0x4E>(x); x += dppx<0x141>(x); x += dppx<0x128>(x); return x; }
__device__ __forceinline__ float asum32(float x) { x = asum16(x); return x + xlane16(x); }
__device__ __forceinline__ float asum64(float x) { return sum_x32(asum32(x)); }
namespace pg8 {
#define PG8_LAS __attribute__((address_space(3)))
typedef unsigned short bf16_t;
typedef short bf16x8 __attribute__((ext_vector_type(8)));
typedef float f32x4 __attribute__((ext_vector_type(4)));
typedef unsigned u32x4 __attribute__((ext_vector_type(4)));
constexpr int BM = 256, BK = 64, HALF = 128, HTB = HALF * BK * 2  , STAGE_BYTES = 8 * HTB, NXCD = 8, WGM = 4;

__host__ __device__ __forceinline__ int lds_byte(int r, int c) { const int st = (r >> 4) * 2 + (c >> 5), rr = r & 15, cc = c & 31, ob = rr * 64 + cc * 2; return st * 1024 + (ob ^ (((ob >> 9) & 1) << 5)); }
__host__ __device__ __forceinline__ void stage_rc(int b, int& R, int& C) { const int st = b / 1024, sb = b % 1024, swz = sb ^ (((sb >> 9) & 1) << 5); R = (st >> 1) * 16 + swz / 64; C = (st & 1) * 32 + (swz % 64) / 2; }
__host__ __device__ __forceinline__ int perm32(int rho) { const int n = rho >> 4, i = rho & 15; return 8 * (i >> 2) + 4 * n + (i & 3); }

struct Unit { int pm, pn; };
struct Gemm { const bf16_t* A; const bf16_t* Bt; int M, N, K; };

struct StaticOrder {
    int nM, nN, nwg, G, c;
    __host__ __device__ void init(int M, int N, int G_, int c_) { nM = M / BM; nN = N / BM; nwg = nM * nN; G = G_; c = c_; }
    __host__ __device__ bool next(int i, Unit& u) const {
        const long L = (long)i * G + c; if (L >= nwg) return false;
        int wgid = (int)L; { const int q = nwg / NXCD, r = nwg % NXCD, xcd = wgid % NXCD, off = wgid / NXCD; wgid = (xcd < r ? xcd * (q + 1) : r * (q + 1) + (xcd - r) * q) + off; }
        const int nig = WGM * nN, gid = wgid / nig, fm = gid * WGM, gsz = (nM - fm) < WGM ? (nM - fm) : WGM;
        u.pm = fm + ((wgid % nig) % gsz); u.pn = (wgid % nig) / gsz; return true;
    }
    __device__ __forceinline__ void a_ready(const Unit&) const {}
    __device__ __forceinline__ void done(const Unit&) const {}
};
struct HotOrder : StaticOrder {
    __host__ __device__ bool next(int i, Unit& u) const { const bool ok = StaticOrder::next(i, u); u.pm = 0; u.pn = 0; return ok; }
};

__device__ __forceinline__ unsigned cvt_pk_bf16(float lo, float hi) { unsigned r; asm volatile("v_cvt_pk_bf16_f32 %0, %1, %2" : "=v"(r) : "v"(lo), "v"(hi)); return r; }
__device__ __forceinline__ float bf_lo(unsigned u) { return __uint_as_float(u << 16); }
__device__ __forceinline__ float bf_hi(unsigned u) { return __uint_as_float(u & 0xffff0000u); }
typedef unsigned u32x2 __attribute__((ext_vector_type(2)));
__device__ __forceinline__ f32x4 ld_bf4(const bf16_t* p) { const u32x2 w = *(const u32x2*)p; return (f32x4){bf_lo(w.x), bf_hi(w.x), bf_lo(w.y), bf_hi(w.y)}; }
__device__ __forceinline__ void st_bf4(bf16_t* p, f32x4 v) { u32x2 w; w.x = cvt_pk_bf16(v[0], v[1]); w.y = cvt_pk_bf16(v[2], v[3]); *(u32x2*)p = w; }
__device__ __forceinline__ float sigmoidf_(float x) { return __builtin_amdgcn_rcpf(1.0f + __expf(-x)); }

struct EpiNull {
    static constexpr bool PERM = true, AFTER_DRAIN = false, ROWPERM = false;
    __device__ __forceinline__ void operator()(const f32x4 (&acc)[2][2][4][2], const Unit&, int, int, int, int) const {
#pragma unroll
        for (int a = 0; a < 2; ++a)
#pragma unroll
            for (int c = 0; c < 2; ++c)
#pragma unroll
                for (int m = 0; m < 4; ++m) { asm volatile("" :: "v"(acc[a][c][m][0])); asm volatile("" :: "v"(acc[a][c][m][1])); }
    }
};
struct RowScale {
    PG8_LAS float* t;
    __device__ __forceinline__ RowScale(const float* rs, PG8_LAS float* SCW, int pm, int wr, int wc, int fr, int fq) {
        const int lane = fq * 16 + fr; t = SCW + (wr * 4 + wc) * 128;
        const float* p = rs + (size_t)(pm * BM + wr * 64 + lane) * 8;
        const f32x4 a0 = *(const f32x4*)p, a1 = *(const f32x4*)(p + 4), b0 = *(const f32x4*)(p + HALF * 8), b1 = *(const f32x4*)(p + HALF * 8 + 4);
        t[lane] = rsqrtf((((a0[0] + a0[1]) + (a0[2] + a0[3])) + ((a1[0] + a1[1]) + (a1[2] + a1[3]))) * (1.0f / 2048.0f) + 1e-6f);
        t[64 + lane] = rsqrtf((((b0[0] + b0[1]) + (b0[2] + b0[3])) + ((b1[0] + b1[1]) + (b1[2] + b1[3]))) * (1.0f / 2048.0f) + 1e-6f);
    }
    __device__ __forceinline__ float operator()(int ai, int m, int fr) const { return t[ai * 64 + m * 16 + fr]; }
};
struct EpiScaleBf16 {
    static constexpr bool PERM = true, AFTER_DRAIN = false, ROWPERM = false;
    bf16_t* O; int ldc; const float* rs; PG8_LAS float* SCW;
    __device__ __forceinline__ void operator()(const f32x4 (&acc)[2][2][4][2], const Unit& u, int wr, int wc, int fr, int fq) const {
        asm volatile("" : "+v"(fr), "+v"(fq));
        const RowScale RSC(rs, SCW, u.pm, wr, wc, fr, fq);
        const int row0 = u.pm * BM + wr * 64 + fr, col0 = u.pn * BM + wc * 32 + 8 * fq;
#pragma unroll
        for (int ai = 0; ai < 2; ++ai)
#pragma unroll
            for (int m = 0; m < 4; ++m) {
                const int row = row0 + ai * HALF + m * 16;
                const float sc = RSC(ai, m, fr);
                bf16_t* rowp = O + (size_t)row * ldc + col0;
#pragma unroll
                for (int bj = 0; bj < 2; ++bj) { const f32x4 v0 = acc[ai][bj][m][0] * sc, v1 = acc[ai][bj][m][1] * sc;
                    u32x4 w; w.x = cvt_pk_bf16(v0[0], v0[1]); w.y = cvt_pk_bf16(v0[2], v0[3]); w.z = cvt_pk_bf16(v1[0], v1[1]); w.w = cvt_pk_bf16(v1[2], v1[3]);
                    *(u32x4*)(rowp + bj * HALF) = w; } }
    }
};
struct EpiProj {
    static constexpr bool PERM = true, AFTER_DRAIN = false, ROWPERM = false;
    bf16_t* O; const float* rs; const float *q_gain, *k_gain; bf16_t *QN, *KN, *VV; float* KMEAN; PG8_LAS float* X; PG8_LAS float* SCW;
    __device__ __forceinline__ void operator()(const f32x4 (&acc)[2][2][4][2], const Unit& u, int wr, int wc, int fr, int fq) const {
        asm volatile("" : "+v"(fr), "+v"(fq));
        const RowScale RSC(rs, SCW, u.pm, wr, wc, fr, fq);
        const int pn = u.pn, d0 = wc * 32 + 8 * fq;
        if (pn >= 12) {
            const int row0 = u.pm * BM + wr * 64 + fr, col0 = pn * BM + d0;
#pragma unroll
            for (int ai = 0; ai < 2; ++ai)
#pragma unroll
                for (int m = 0; m < 4; ++m) { const int row = row0 + ai * HALF + m * 16; const float sc = RSC(ai, m, fr); bf16_t* rowp = O + (size_t)row * 6656 + col0;
#pragma unroll
                    for (int bj = 0; bj < 2; ++bj) { const f32x4 v0 = acc[ai][bj][m][0] * sc, v1 = acc[ai][bj][m][1] * sc;
                        u32x4 w; w.x = cvt_pk_bf16(v0[0], v0[1]); w.y = cvt_pk_bf16(v0[2], v0[3]); w.z = cvt_pk_bf16(v1[0], v1[1]); w.w = cvt_pk_bf16(v1[2], v1[3]);
                        *(u32x4*)(rowp + bj * HALF) = w; } }
            return; }
        const int typ = pn >> 2, hb = 2 * (pn & 3), bb = u.pm >> 3, blk = u.pm & 7;
        if (typ == 2) {
#pragma unroll
            for (int ai = 0; ai < 2; ++ai)
#pragma unroll
                for (int m = 0; m < 4; ++m) { const int rl = ai * HALF + wr * 64 + m * 16 + fr; const float sc = RSC(ai, m, fr);
#pragma unroll
                    for (int bj = 0; bj < 2; ++bj) { const f32x4 v0 = acc[ai][bj][m][0] * sc, v1 = acc[ai][bj][m][1] * sc;
                        u32x4 w; w.x = cvt_pk_bf16(v0[0], v0[1]); w.y = cvt_pk_bf16(v0[2], v0[3]); w.z = cvt_pk_bf16(v1[0], v1[1]); w.w = cvt_pk_bf16(v1[2], v1[3]);
                        *(u32x4*)(VV + (((size_t)bb * 8 + hb + bj) * 2048 + blk * 256 + rl) * 128 + d0) = w; } }
            return; }
#pragma unroll
        for (int ai = 0; ai < 2; ++ai)
#pragma unroll
            for (int m = 0; m < 4; ++m) { const int rl = ai * HALF + wr * 64 + m * 16 + fr; const float sc = RSC(ai, m, fr);
#pragma unroll
                for (int bj = 0; bj < 2; ++bj) { const f32x4 v0 = acc[ai][bj][m][0] * sc, v1 = acc[ai][bj][m][1] * sc;
                    float ss = (v0[0] * v0[0] + v0[1] * v0[1]) + (v0[2] * v0[2] + v0[3] * v0[3]) + (v1[0] * v1[0] + v1[1] * v1[1]) + (v1[2] * v1[2] + v1[3] * v1[3]);
                    ss = xsum_rows4(ss);
                    if (fq == 0) X[(rl * 4 + wc) * 2 + bj] = ss; } }
        asm volatile("s_waitcnt lgkmcnt(0)" ::: "memory"); __builtin_amdgcn_s_barrier(); asm volatile("" ::: "memory");
        const float* gain = typ ? k_gain : q_gain; bf16_t* dst = typ ? KN : QN;
        const f32x4 g0 = *(const f32x4*)(gain + d0), g1 = *(const f32x4*)(gain + d0 + 4);
#pragma unroll
        for (int ai = 0; ai < 2; ++ai)
#pragma unroll
            for (int m = 0; m < 4; ++m) { const int rl = ai * HALF + wr * 64 + m * 16 + fr; const float sc = RSC(ai, m, fr);
                const f32x4 xa = *(const PG8_LAS f32x4*)(X + rl * 8), xb_ = *(const PG8_LAS f32x4*)(X + rl * 8 + 4);
#pragma unroll
                for (int bj = 0; bj < 2; ++bj) { const float tot = bj ? (xa[1] + xa[3]) + (xb_[1] + xb_[3]) : (xa[0] + xa[2]) + (xb_[0] + xb_[2]);
                    const float f = sc * rsqrtf(tot * (1.0f / 128.0f) + 1e-6f);
                    const f32x4 v0 = acc[ai][bj][m][0] * f * g0, v1 = acc[ai][bj][m][1] * f * g1;
                    u32x4 w; w.x = cvt_pk_bf16(v0[0], v0[1]); w.y = cvt_pk_bf16(v0[2], v0[3]); w.z = cvt_pk_bf16(v1[0], v1[1]); w.w = cvt_pk_bf16(v1[2], v1[3]);
                    *(u32x4*)(dst + (((size_t)bb * 8 + hb + bj) * 2048 + blk * 256 + rl) * 128 + d0) = w; } }
    }
};
struct EpiResid {
    static constexpr bool PERM = true, AFTER_DRAIN = false, ROWPERM = false;
    float* xout; bf16_t* xb; float* rs_out; PG8_LAS float* X;
    __device__ __forceinline__ void operator()(const f32x4 (&acc)[2][2][4][2], const Unit& u, int wr, int wc, int fr, int fq) const {
        asm volatile("" : "+v"(fr), "+v"(fq));
        const int row0 = u.pm * BM + wr * 64 + fr, col0 = u.pn * BM + wc * 32 + 8 * fq;
        bf16_t* base = xb + (size_t)row0 * 2048 + col0;
        u32x4 xo[2][4][2];
#pragma unroll
        for (int ai = 0; ai < 2; ++ai)
#pragma unroll
            for (int m = 0; m < 4; ++m) { const bf16_t* p = base + (size_t)(ai * HALF + m * 16) * 2048; xo[ai][m][0] = *(const u32x4*)p; xo[ai][m][1] = *(const u32x4*)(p + HALF); }
#pragma unroll
        for (int ai = 0; ai < 2; ++ai)
#pragma unroll
            for (int m = 0; m < 4; ++m) {
                const size_t off = (size_t)(row0 + ai * HALF + m * 16) * 2048 + col0; float ss = 0.f;
#pragma unroll
                for (int bj = 0; bj < 2; ++bj) { const u32x4 xw = xo[ai][m][bj];
                    const f32x4 v0 = acc[ai][bj][m][0] + (f32x4){bf_lo(xw.x), bf_hi(xw.x), bf_lo(xw.y), bf_hi(xw.y)}, v1 = acc[ai][bj][m][1] + (f32x4){bf_lo(xw.z), bf_hi(xw.z), bf_lo(xw.w), bf_hi(xw.w)};
                    if (xout) { *(f32x4*)(xout + off + bj * HALF) = v0; *(f32x4*)(xout + off + bj * HALF + 4) = v1; continue; }
                    u32x4 w; w.x = cvt_pk_bf16(v0[0], v0[1]); w.y = cvt_pk_bf16(v0[2], v0[3]); w.z = cvt_pk_bf16(v1[0], v1[1]); w.w = cvt_pk_bf16(v1[2], v1[3]);
                    *(u32x4*)(xb + off + bj * HALF) = w;
                    ss += (v0[0] * v0[0] + v0[1] * v0[1]) + (v0[2] * v0[2] + v0[3] * v0[3]) + (v1[0] * v1[0] + v1[1] * v1[1]) + (v1[2] * v1[2] + v1[3] * v1[3]); }
                if (xout) continue;
                ss = xsum_rows4(ss);
                if (fq == 0) X[(ai * HALF + wr * 64 + m * 16 + fr) * 4 + wc] = ss; }
        if (xout) return;
        asm volatile("s_waitcnt lgkmcnt(0)" ::: "memory"); __builtin_amdgcn_s_barrier(); asm volatile("" ::: "memory");
        if (wc == 0) {
            const int lane = fq * 16 + fr;
#pragma unroll
            for (int ai = 0; ai < 2; ++ai) { const int rl = ai * HALF + wr * 64 + lane; const f32x4 xs = *(const PG8_LAS f32x4*)(X + rl * 4);
                rs_out[(size_t)(u.pm * BM + rl) * 8 + u.pn] = (xs[0] + xs[1]) + (xs[2] + xs[3]); } }
    }
};
template <int NQ> struct TapTable {
    PG8_LAS float* t;
    __device__ __forceinline__ TapTable(PG8_LAS float* base, int wr, int wc) { t = base + (wr * 4 + wc) * 256; }
    __device__ __forceinline__ void put(int idx, f32x4 v) const { *(PG8_LAS f32x4*)(t + idx * 4) = v; }
    __device__ __forceinline__ f32x4 get(int n, int q, int fq) const { return *(const PG8_LAS f32x4*)(t + ((n * NQ + q) * 4 + fq) * 4); }
};
template <int CTRL> __device__ __forceinline__ float dpp_upd(float old, float src) { return __builtin_bit_cast(float, __builtin_amdgcn_update_dpp(__builtin_bit_cast(int, old), __builtin_bit_cast(int, src), CTRL, 0xf, 0xf, false)); }
template <int CTRL> __device__ __forceinline__ float dpp_mov(float src) { return __builtin_bit_cast(float, __builtin_amdgcn_mov_dpp(__builtin_bit_cast(int, src), CTRL, 0xf, 0xf, true)); }
__device__ __forceinline__ float row_prev1(float cur, float prevm) { return dpp_upd<0x111>(dpp_mov<0x121>(prevm), cur); }
__device__ __forceinline__ float row_prev2(float cur, float prevm) { return dpp_upd<0x112>(dpp_mov<0x122>(prevm), cur); }
struct EpiUpConv {
    static constexpr bool PERM = true, AFTER_DRAIN = false, ROWPERM = true;
    bf16_t* ACT; bf16_t* HALO; const float* rs; PG8_LAS float* SCW; const float* cw; PG8_LAS float* TAPS;
    __device__ __forceinline__ void operator()(const f32x4 (&acc)[2][2][4][2], const Unit& u, int wr, int wc, int fr, int fq) const {
        asm volatile("" : "+v"(fr), "+v"(fq));
        const int c0 = wc * 32 + 8 * fq;
        const TapTable<6> TT(TAPS, wr, wc);
        { int idx = fq * 16 + fr; if (idx >= 48) idx -= 16; const int n_ = idx / 24, q_ = (idx >> 2) % 6, f_ = idx & 3;
          TT.put(idx, *(const f32x4*)(cw + (q_ % 3) * 11264 + (q_ >= 3 ? 5632 : 0) + u.pn * 128 + wc * 32 + 8 * f_ + 4 * n_)); }
        const RowScale RSC(rs, SCW, u.pm, wr, wc, fr, fq);
#pragma unroll
        for (int ai = 0; ai < 2; ++ai) {
            const int sg = u.pm * 4 + ai * 2 + wr;
            const f32x4 sc = *(const PG8_LAS f32x4*)(RSC.t + ai * 64 + 4 * fr);
            unsigned pk0[4][2];
#pragma unroll
            for (int n = 0; n < 2; ++n) {
                const int chg = u.pn * 128 + c0 + 4 * n;
                const f32x4 g0 = TT.get(n, 0, fq), g1 = TT.get(n, 1, fq), g2 = TT.get(n, 2, fq), v0 = TT.get(n, 3, fq), v1 = TT.get(n, 4, fq), v2 = TT.get(n, 5, fq);
                f32x4 hg[4], hv[4];
#pragma unroll
                for (int m = 0; m < 4; ++m) { hg[m] = acc[ai][0][m][n] * sc[m]; hv[m] = acc[ai][1][m][n] * sc[m]; }
                f32x4 gm1, gm2, vm1, vm2;
#pragma unroll
                for (int e = 0; e < 4; ++e) { gm1[e] = dpp_mov<0x111>(hg[3][e]); gm2[e] = dpp_mov<0x111>(hg[2][e]); vm1[e] = dpp_mov<0x111>(hv[3][e]); vm2[e] = dpp_mov<0x111>(hv[2][e]); }
#pragma unroll
                for (int m = 0; m < 4; ++m) {
                    const f32x4 ga = m >= 2 ? hg[m - 2] : (m == 1 ? gm1 : gm2), gb = m >= 1 ? hg[m - 1] : gm1, va = m >= 2 ? hv[m - 2] : (m == 1 ? vm1 : vm2), vb = m >= 1 ? hv[m - 1] : vm1;
                    const f32x4 cg = g0 * ga + g1 * gb + g2 * hg[m], cv = v0 * va + v1 * vb + v2 * hv[m]; f32x4 o;
#pragma unroll
                    for (int e = 0; e < 4; ++e) o[e] = cg[e] * sigmoidf_(cg[e]) * cv[e];
                    const int row = u.pm * BM + ai * HALF + wr * 64 + 4 * fr + m;
                    const bool head = (m < 2) && (fr == 0), tail = (m >= 2) && (fr == 15);
                    if (n == 0) { pk0[m][0] = cvt_pk_bf16(o[0], o[1]); pk0[m][1] = cvt_pk_bf16(o[2], o[3]); }
                    else if (!head) { u32x4 w; w.x = pk0[m][0]; w.y = pk0[m][1]; w.z = cvt_pk_bf16(o[0], o[1]); w.w = cvt_pk_bf16(o[2], o[3]); *(u32x4*)(ACT + (size_t)row * 5632 + chg - 4) = w; }
                    if (head || tail) { bf16_t* hp = HALO + ((size_t)sg * 4 + m) * 11264 + u.pn * BM + c0 + 4 * n; st_bf4(hp, hg[m]); st_bf4(hp + HALF, hv[m]); }
                }
            }
            asm volatile("" ::: "memory");
        }
    }
};
struct EpiCU {
    static constexpr bool PERM = true, AFTER_DRAIN = false, ROWPERM = true;
    bf16_t* CV; bf16_t* HALO; const float* rs; PG8_LAS float* SCW; const float* cw; PG8_LAS float* TAPS;
    __device__ __forceinline__ void operator()(const f32x4 (&acc)[2][2][4][2], const Unit& u, int wr, int wc, int fr, int fq) const {
        asm volatile("" : "+v"(fr), "+v"(fq));
        const int c0 = wc * 32 + 8 * fq;
        const TapTable<3> TT(TAPS, wr, wc);
        { int idx = fq * 16 + fr; if (idx >= 48) idx -= 24; if (idx >= 24) idx -= 24; const int n_ = idx / 12, q_ = (idx >> 2) % 3, f_ = idx & 3;
          TT.put(idx, *(const f32x4*)(cw + q_ * 2048 + u.pn * 128 + wc * 32 + 8 * f_ + 4 * n_)); }
        const RowScale RSC(rs, SCW, u.pm, wr, wc, fr, fq);
#pragma unroll
        for (int ai = 0; ai < 2; ++ai) {
            const int sg = u.pm * 4 + ai * 2 + wr;
            const f32x4 sc = *(const PG8_LAS f32x4*)(RSC.t + ai * 64 + 4 * fr);
            unsigned pk0[4][2];
#pragma unroll
            for (int n = 0; n < 2; ++n) {
                const int ch = u.pn * 128 + c0 + 4 * n;
                const f32x4 g0 = TT.get(n, 0, fq), g1 = TT.get(n, 1, fq), g2 = TT.get(n, 2, fq);
                f32x4 cu[4];
#pragma unroll
                for (int m = 0; m < 4; ++m) cu[m] = (acc[ai][0][m][n] * sc[m]) * (acc[ai][1][m][n] * sc[m]);
                f32x4 cm1, cm2;
#pragma unroll
                for (int e = 0; e < 4; ++e) { cm1[e] = dpp_mov<0x111>(cu[3][e]); cm2[e] = dpp_mov<0x111>(cu[2][e]); }
#pragma unroll
                for (int m = 0; m < 4; ++m) {
                    const f32x4 ca = m >= 2 ? cu[m - 2] : (m == 1 ? cm1 : cm2), cb = m >= 1 ? cu[m - 1] : cm1;
                    const f32x4 o = g0 * ca + g1 * cb + g2 * cu[m];
                    const int row = u.pm * BM + ai * HALF + wr * 64 + 4 * fr + m;
                    const bool head = (m < 2) && (fr == 0), tail = (m >= 2) && (fr == 15);
                    if (n == 0) { pk0[m][0] = cvt_pk_bf16(o[0], o[1]); pk0[m][1] = cvt_pk_bf16(o[2], o[3]); }
                    else if (!head) { u32x4 w; w.x = pk0[m][0]; w.y = pk0[m][1]; w.z = cvt_pk_bf16(o[0], o[1]); w.w = cvt_pk_bf16(o[2], o[3]); *(u32x4*)(CV + (size_t)row * 2048 + ch - 4) = w; }
                    if (head || tail) st_bf4(HALO + ((size_t)sg * 4 + m) * 2048 + ch, cu[m]);
                }
            }
            asm volatile("" ::: "memory");
        }
    }
};
struct EpiGateB {
    static constexpr bool PERM = true, AFTER_DRAIN = false, ROWPERM = false;
    bf16_t* O; const bf16_t* CV; const float* rs; PG8_LAS float* SCW;
    __device__ __forceinline__ void operator()(const f32x4 (&acc)[2][2][4][2], const Unit& u, int wr, int wc, int fr, int fq) const {
        asm volatile("" : "+v"(fr), "+v"(fq));
        const RowScale RSC(rs, SCW, u.pm, wr, wc, fr, fq);
        const int row0 = u.pm * BM + wr * 64 + fr, col0 = u.pn * BM + wc * 32 + 8 * fq;
#pragma unroll
        for (int ai = 0; ai < 2; ++ai)
#pragma unroll
            for (int m = 0; m < 4; ++m) {
                const int row = row0 + ai * HALF + m * 16;
                const float sc = RSC(ai, m, fr);
#pragma unroll
                for (int bj = 0; bj < 2; ++bj) { const size_t o = (size_t)row * 2048 + col0 + bj * HALF;
                    const u32x4 cw_ = *(const u32x4*)(CV + o);
                    const f32x4 v0 = acc[ai][bj][m][0] * sc, v1 = acc[ai][bj][m][1] * sc;
                    u32x4 w; w.x = cvt_pk_bf16(v0[0] * bf_lo(cw_.x), v0[1] * bf_hi(cw_.x)); w.y = cvt_pk_bf16(v0[2] * bf_lo(cw_.y), v0[3] * bf_hi(cw_.y));
                    w.z = cvt_pk_bf16(v1[0] * bf_lo(cw_.z), v1[1] * bf_hi(cw_.z)); w.w = cvt_pk_bf16(v1[2] * bf_lo(cw_.w), v1[3] * bf_hi(cw_.w));
                    *(u32x4*)(O + o) = w; } }
    }
};
struct EpiLora {
    static constexpr bool PERM = false, AFTER_DRAIN = false, ROWPERM = false;
    const bf16_t* proj;
    const float *shift_mu, *w0, *a0, *v0, *k_k, *k_a, *r_k;
    bf16_t* vfirst;
    unsigned *P0, *P1, *P2, *P3; float* PC; float* BON;
    PG8_LAS float* X;
    struct Raw { u32x2 rc, rp, kc, kp, vc, vp, vf; };
    __device__ __forceinline__ static f32x4 up4(u32x2 w) { return (f32x4){bf_lo(w.x), bf_hi(w.x), bf_lo(w.y), bf_hi(w.y)}; }
    __device__ __forceinline__ void operator()(const f32x4 (&acc)[2][2][4][2], const Unit& u, int wr, int wc, int fr, int fq) const {
        const int h = u.pn, ch = 64 * h + 16 * wc + 4 * fq;
        const f32x4 mu_k = *(const f32x4*)(shift_mu + 1024 + ch), kkc = *(const f32x4*)(k_k + ch);
        u32x2 kc8[8], kp8[8];
#pragma unroll
        for (int g = 0; g < 8; ++g) { const int rl = (g >> 2) * HALF + wr * 64 + (g & 3) * 16 + fr, tok = u.pm * BM + rl; const int tp = (tok & 2047) ? tok - 1 : tok;
            kc8[g] = *(const u32x2*)(proj + (size_t)tok * 6656 + 4096 + ch); kp8[g] = *(const u32x2*)(proj + (size_t)tp * 6656 + 4096 + ch); }
#pragma unroll
        for (int g = 0; g < 8; ++g) { const int rl = (g >> 2) * HALF + wr * 64 + (g & 3) * 16 + fr, tok = u.pm * BM + rl;
            const f32x4 kc = up4(kc8[g]); f32x4 kp = up4(kp8[g]); if ((tok & 2047) == 0) kp = (f32x4){0.f, 0.f, 0.f, 0.f};
            const f32x4 ks = kc + mu_k * (kp - kc), kk = ks * kkc;
            float ss = (kk[0] * kk[0] + kk[1] * kk[1]) + (kk[2] * kk[2] + kk[3] * kk[3]);
            ss = xsum_rows4(ss);
            if (fq == 0) X[rl * 4 + wc] = ss; }
        asm volatile("s_waitcnt lgkmcnt(0)" ::: "memory"); __builtin_amdgcn_s_barrier(); asm volatile("" ::: "memory");
        const f32x4 kac = *(const f32x4*)(k_a + ch), w0c = *(const f32x4*)(w0 + ch), mu_r = *(const f32x4*)(shift_mu + ch), mu_v = *(const f32x4*)(shift_mu + 2048 + ch), rkc = *(const f32x4*)(r_k + ch);
        Raw ra;
#define E3_LOAD(dst, g) do { const int rl_ = ((g) >> 2) * HALF + wr * 64 + ((g) & 3) * 16 + fr, tok_ = u.pm * BM + rl_; const int tp_ = (tok_ & 2047) ? tok_ - 1 : tok_; \
            const bf16_t* pc_ = proj + (size_t)tok_ * 6656 + ch; const bf16_t* pp_ = proj + (size_t)tp_ * 6656 + ch; \
            dst.rc = *(const u32x2*)(pc_ + 3072); dst.kc = *(const u32x2*)(pc_ + 4096); dst.vc = *(const u32x2*)(pc_ + 5120); \
            dst.rp = *(const u32x2*)(pp_ + 3072); dst.kp = *(const u32x2*)(pp_ + 4096); dst.vp = *(const u32x2*)(pp_ + 5120); \
            dst.vf = v0 ? *(const u32x2*)(vfirst + (size_t)tok_ * 1024 + ch) : (u32x2){0u, 0u}; } while (0)
#define E3_SCAN1(x, c) x += __builtin_bit_cast(float, __builtin_amdgcn_update_dpp(0, __builtin_bit_cast(int, x), c, 0xf, 0xf, true))
#define E3_BODY(g, cur) do { \
            const int ai = g >> 2, m = g & 3; \
            const int rl = ai * HALF + wr * 64 + m * 16 + fr, tok = u.pm * BM + rl; const bool first = (tok & 2047) == 0; const size_t o = (size_t)tok * 1024 + ch; \
            const u32x2 zz_ = (u32x2){0u, 0u}; const u32x2 rpw = first ? zz_ : cur.rp, kpw = first ? zz_ : cur.kp, vpw = first ? zz_ : cur.vp; \
            const f32x4 xs = *(const PG8_LAS f32x4*)(X + rl * 4); \
            const float inv = __builtin_amdgcn_rsqf(fmaxf((xs[0] + xs[1]) + (xs[2] + xs[3]), 1e-24f));         \
            const f32x4 apre = acc[ai][0][m][1], wpre = acc[ai][0][m][0] + w0c, gg = acc[ai][1][m][0]; \
            f32x4 vs; { const f32x4 vc = up4(cur.vc), vp = up4(vpw); vs = vc + mu_v * (vp - vc); } \
            f32x4 vo; u32x4 w0_, w1_, w2_, w3_; float bon = 0.f; \
            if (v0) { const f32x4 vf = up4(cur.vf), vpre = acc[ai][1][m][1]; \
                _Pragma("unroll") for (int j = 0; j < 4; ++j) vo[j] = vs[j] + (vf[j] - vs[j]) * sigmoidf_(vpre[j]); } \
            else { vo = vs; st_bf4(vfirst + o, vs); } \
            float Lj[4]; \
            _Pragma("unroll") for (int j = 0; j < 4; ++j) Lj[j] = -0.60653066f * sigmoidf_(wpre[j]);       \
            _Pragma("unroll") for (int j = 0; j < 4; ++j) E3_SCAN1(Lj[j], 0x111); \
            _Pragma("unroll") for (int j = 0; j < 4; ++j) E3_SCAN1(Lj[j], 0x112); \
            _Pragma("unroll") for (int j = 0; j < 4; ++j) E3_SCAN1(Lj[j], 0x114); \
            _Pragma("unroll") for (int j = 0; j < 4; ++j) E3_SCAN1(Lj[j], 0x118); \
            _Pragma("unroll") for (int j = 0; j < 4; ++j) { \
                const unsigned rcw_ = cur.rc[j >> 1], rpw_ = rpw[j >> 1], kcw_ = cur.kc[j >> 1], kpw_ = kpw[j >> 1]; \
                const float rc_ = (j & 1) ? bf_hi(rcw_) : bf_lo(rcw_), rp_ = (j & 1) ? bf_hi(rpw_) : bf_lo(rpw_), kc_ = (j & 1) ? bf_hi(kcw_) : bf_lo(kcw_), kp_ = (j & 1) ? bf_hi(kpw_) : bf_lo(kpw_); \
                const float rsj = rc_ + mu_r[j] * (rp_ - rc_), ksj = kc_ + mu_k[j] * (kp_ - kc_); \
                const float a = sigmoidf_(apre[j]), kkn = ksj * kkc[j] * inv; \
                const float ko_ = ksj * (1.0f + (a - 1.0f) * kac[j]), as_ = -kkn, bs_ = kkn * a; bon += rsj * ko_ * rkc[j]; \
                const float e2 = __expf(Lj[j]), e3 = __builtin_amdgcn_rcpf(e2);                                \
                const float e1 = __builtin_bit_cast(float, __builtin_amdgcn_update_dpp(0x3f800000, __builtin_bit_cast(int, e2), 0x111, 0xf, 0xf, false));     \
                const float e4 = e3 * dppx<0x15F>(e2);                                                          \
                w0_[j] = cvt_pk_bf16(as_ * e1, rsj * e2); w1_[j] = cvt_pk_bf16(bs_ * e3, ko_ * e3); w2_[j] = cvt_pk_bf16(bs_ * e4, ko_ * e4); w3_[j] = cvt_pk_bf16(vo[j], gg[j]); \
                vo[j] = e2; } \
            *(u32x4*)(P0 + o) = w0_; *(u32x4*)(P1 + o) = w1_; *(u32x4*)(P2 + o) = w2_; *(u32x4*)(P3 + o) = w3_; \
            if (fr == 15) *(f32x4*)(PC + (size_t)(tok >> 4) * 1024 + ch) = vo; \
            bon = xsum_rows4(bon); \
            if (fq == 0) X[1024 + rl * 4 + wc] = bon; \
        } while (0)
#pragma unroll
        for (int g2 = 0; g2 < 8; ++g2) {
            E3_LOAD(ra, g2);
            E3_BODY(g2, ra);
            asm volatile("" ::: "memory");
        }
#undef E3_BODY
#undef E3_SCAN1
#undef E3_LOAD
        asm volatile("s_waitcnt lgkmcnt(0)" ::: "memory"); __builtin_amdgcn_s_barrier(); asm volatile("" ::: "memory");
        if (wc == 0) {
            const int lane = fq * 16 + fr;
#pragma unroll
            for (int ai = 0; ai < 2; ++ai) { const int rl = ai * HALF + wr * 64 + lane; const f32x4 xs = *(const PG8_LAS f32x4*)(X + 1024 + rl * 4);
                BON[(size_t)(u.pm * BM + rl) * 16 + h] = (xs[0] + xs[1]) + (xs[2] + xs[3]); } }
    }
};

template <class Epi, class Sched, bool ALIGN_EPI = false, bool SP2 = false>
__device__ __forceinline__ void gemm_phase(PG8_LAS unsigned char* lds, const Gemm g, const Sched& S, const Epi& E, const int wave_in) {
    const int wid = wave_in, lane = lane_id_opaque(), tid = wid * 64 + lane, wr = wid >> 2, wc = wid & 3, fr = lane & 15, fq = lane >> 4;
    int K_o = g.K; asm volatile("" : "+s"(K_o));
    const int K = K_o, nt = K / BK;
    unsigned voffA[2], voffB[2];
#pragma unroll
    for (int i = 0; i < 2; ++i) { int R, C; stage_rc(tid * 16 + i * 8192, R, C); const int Rb = Epi::PERM ? ((R & ~31) + perm32(R & 31)) : R;
        const int Ra = Epi::ROWPERM ? ((R & ~63) + 4 * (R & 15) + ((R >> 4) & 3)) : R;
        voffA[i] = (unsigned)(Ra * K + C) * 2u; voffB[i] = (unsigned)(Rb * K + C) * 2u; }
    const size_t kstep = (size_t)(BK * 2);
    const size_t hstep = (size_t)HALF * K * 2;
    const size_t tstep = 2 * hstep;
    const unsigned ldsw = (unsigned)wid * 1024u;
    const int aoff = lds_byte(wr * 64 + fr, fq * 8), boff = lds_byte(wc * 32 + fr, fq * 8);
#define PG8_SA(b, h) (((b) * 2 + (h)) * HTB)
#define PG8_SB(b, h) ((4 + (b) * 2 + (h)) * HTB)
#define PG8_STAGE(bufoff, gbase, voff) do { _Pragma("unroll") for (int _i = 0; _i < 2; ++_i) \
        __builtin_amdgcn_global_load_lds((const unsigned*)((const char*)(gbase) + (voff)[_i]), (PG8_LAS unsigned*)(lds + (bufoff) + ldsw + _i * 8192), 16, 0, 0); } while (0)
#define PG8_LDA(dst, b, h) do { _Pragma("unroll") for (int m = 0; m < 4; ++m) _Pragma("unroll") for (int k = 0; k < 2; ++k) dst[m][k] = *(const PG8_LAS bf16x8*)(lds + PG8_SA(b, h) + aoff + m * 2048 + k * 1024); } while (0)
#define PG8_LDB(dst, b, h) do { _Pragma("unroll") for (int n = 0; n < 2; ++n) _Pragma("unroll") for (int k = 0; k < 2; ++k) dst[n][k] = *(const PG8_LAS bf16x8*)(lds + PG8_SB(b, h) + boff + n * 2048 + k * 1024); } while (0)
#ifdef KL_NOPRIO
#define PG8_PRIO(x)
#else
#define PG8_PRIO(x) __builtin_amdgcn_s_setprio(x)
#endif
#define PG8_MMA(ai, bj, At, Bt) do { PG8_PRIO(1); _Pragma("unroll") for (int m = 0; m < 4; ++m) _Pragma("unroll") for (int n = 0; n < 2; ++n) _Pragma("unroll") for (int k = 0; k < 2; ++k) \
        acc[ai][bj][m][n] = __builtin_amdgcn_mfma_f32_16x16x32_bf16(Bt[n][k], At[m][k], acc[ai][bj][m][n], 0, 0, 0); PG8_PRIO(0); } while (0)
#define PG8_WAIT_V(n) asm volatile("s_waitcnt vmcnt(" #n ")" ::: "memory")
#define PG8_WAIT_L(n) asm volatile("s_waitcnt lgkmcnt(" #n ")" ::: "memory")
#define PG8_BAR __builtin_amdgcn_s_barrier()
#ifdef KL_NOSCHED
#define PG8_SCHED
#else
#define PG8_SCHED __builtin_amdgcn_sched_barrier(0)
#endif
    Unit cur, nxt; int ui = 0;
    if (!S.next(0, cur)) return;
    f32x4 acc[2][2][4][2];
#pragma unroll
    for (int a = 0; a < 2; ++a)
#pragma unroll
        for (int b = 0; b < 2; ++b)
#pragma unroll
            for (int m = 0; m < 4; ++m)
#pragma unroll
                for (int n = 0; n < 2; ++n) acc[a][b][m][n] = (f32x4){0.f, 0.f, 0.f, 0.f};
    bf16x8 At[4][2], B0[2][2], B1[2][2];
    const char* cA = (const char*)g.A + (size_t)cur.pm * tstep; const char* cB = (const char*)g.Bt + (size_t)cur.pn * tstep;
    S.a_ready(cur);
    if constexpr (SP2) {
        PG8_STAGE(PG8_SB(0, 0), cB, voffB); PG8_STAGE(PG8_SB(0, 1), cB + hstep, voffB); PG8_STAGE(PG8_SA(0, 0), cA, voffA); PG8_STAGE(PG8_SA(0, 1), cA + hstep, voffA);
        if (wr == 1) PG8_BAR;
        PG8_WAIT_V(2); PG8_BAR;
        PG8_STAGE(PG8_SB(1, 0), cB + kstep, voffB); PG8_STAGE(PG8_SA(1, 0), cA + kstep, voffA); PG8_STAGE(PG8_SB(1, 1), cB + hstep + kstep, voffB);
        PG8_WAIT_V(6); PG8_BAR;
    } else {
        PG8_STAGE(PG8_SB(0, 0), cB, voffB); PG8_STAGE(PG8_SA(0, 0), cA, voffA); PG8_STAGE(PG8_SB(0, 1), cB + hstep, voffB); PG8_STAGE(PG8_SA(0, 1), cA + hstep, voffA);
        if (wr == 1) PG8_BAR;
        PG8_WAIT_V(4); PG8_BAR;
        PG8_STAGE(PG8_SB(1, 0), cB + kstep, voffB); PG8_STAGE(PG8_SA(1, 0), cA + kstep, voffA); PG8_STAGE(PG8_SB(1, 1), cB + hstep + kstep, voffB);
        PG8_WAIT_V(6); PG8_BAR;
    }
    for (;;) {
        const bool has_next = S.next(ui + 1, nxt);
        const char* nA = has_next ? (const char*)g.A + (size_t)nxt.pm * tstep : cA; const char* nB = has_next ? (const char*)g.Bt + (size_t)nxt.pn * tstep : cB;
        for (int t = 0; t < nt; t += 2) {
            const bool last = (t == nt - 2);
            const char* a1 = cA + (size_t)(t + 1) * kstep;
            const char* a2 = last ? nA : cA + (size_t)(t + 2) * kstep; const char* b2 = last ? nB : cB + (size_t)(t + 2) * kstep;
            const char* a3 = a2 + kstep; const char* b3 = b2 + kstep;
            if (last && has_next) S.a_ready(nxt);
            if constexpr (SP2) {
            PG8_LDB(B0, 0, 0); PG8_LDB(B1, 0, 1); PG8_SCHED; PG8_LDA(At, 0, 0); PG8_STAGE(PG8_SA(1, 1), a1 + hstep, voffA);
            PG8_WAIT_V(8); PG8_WAIT_L(0); PG8_BAR; PG8_MMA(0, 0, At, B0); PG8_MMA(0, 1, At, B1); PG8_BAR; PG8_SCHED;
            PG8_LDA(At, 0, 1); PG8_STAGE(PG8_SB(0, 0), b2, voffB); PG8_STAGE(PG8_SB(0, 1), b2 + hstep, voffB); PG8_STAGE(PG8_SA(0, 0), a2, voffA);
            PG8_WAIT_V(8); PG8_WAIT_L(0); PG8_BAR; PG8_MMA(1, 0, At, B0); PG8_MMA(1, 1, At, B1); PG8_BAR; PG8_SCHED;
            PG8_LDB(B0, 1, 0); PG8_LDB(B1, 1, 1); PG8_SCHED; PG8_LDA(At, 1, 0); PG8_STAGE(PG8_SA(0, 1), a2 + hstep, voffA);
            PG8_WAIT_V(8); PG8_WAIT_L(0); PG8_BAR; PG8_MMA(0, 0, At, B0); PG8_MMA(0, 1, At, B1); PG8_BAR; PG8_SCHED;
            PG8_LDA(At, 1, 1); PG8_STAGE(PG8_SB(1, 0), b3, voffB); PG8_STAGE(PG8_SB(1, 1), b3 + hstep, voffB); PG8_STAGE(PG8_SA(1, 0), a3, voffA);
            PG8_WAIT_V(8); PG8_WAIT_L(0); PG8_BAR; PG8_MMA(1, 0, At, B0); PG8_MMA(1, 1, At, B1); PG8_BAR; PG8_SCHED;
            } else {
            PG8_LDB(B0, 0, 0); PG8_SCHED; PG8_LDA(At, 0, 0); PG8_STAGE(PG8_SA(1, 1), a1 + hstep, voffA);
            PG8_WAIT_L(8); PG8_BAR; PG8_WAIT_L(0); PG8_MMA(0, 0, At, B0); PG8_BAR; PG8_SCHED;
            PG8_LDB(B1, 0, 1); PG8_STAGE(PG8_SB(0, 0), b2, voffB);
            PG8_BAR; PG8_WAIT_L(0); PG8_MMA(0, 1, At, B1); PG8_BAR;
            PG8_LDA(At, 0, 1); PG8_STAGE(PG8_SA(0, 0), a2, voffA);
            PG8_BAR; PG8_WAIT_L(0); PG8_MMA(1, 0, At, B0); PG8_BAR; PG8_SCHED;
            PG8_STAGE(PG8_SB(0, 1), b2 + hstep, voffB);
            PG8_WAIT_V(6); PG8_BAR; PG8_MMA(1, 1, At, B1); PG8_BAR;
            PG8_LDB(B0, 1, 0); PG8_SCHED; PG8_LDA(At, 1, 0); PG8_STAGE(PG8_SA(0, 1), a2 + hstep, voffA);
            PG8_WAIT_L(8); PG8_BAR; PG8_WAIT_L(0); PG8_MMA(0, 0, At, B0); PG8_BAR; PG8_SCHED;
            PG8_LDB(B1, 1, 1); PG8_STAGE(PG8_SB(1, 0), b3, voffB);
            PG8_BAR; PG8_WAIT_L(0); PG8_MMA(0, 1, At, B1); PG8_BAR;
            PG8_LDA(At, 1, 1); PG8_STAGE(PG8_SA(1, 0), a3, voffA);
            PG8_BAR; PG8_WAIT_L(0); PG8_MMA(1, 0, At, B0); PG8_BAR; PG8_SCHED;
            PG8_STAGE(PG8_SB(1, 1), b3 + hstep, voffB);
            PG8_WAIT_V(6); PG8_BAR; PG8_MMA(1, 1, At, B1); PG8_BAR;
            }
        }
        if constexpr (ALIGN_EPI) { if (wr == 0) PG8_BAR; }
        if constexpr (!Epi::AFTER_DRAIN) { E(acc, cur, wr, wc, fr, fq); S.done(cur); }
        if (!has_next) break;
#pragma unroll
        for (int a = 0; a < 2; ++a)
#pragma unroll
            for (int b = 0; b < 2; ++b)
#pragma unroll
                for (int m = 0; m < 4; ++m)
#pragma unroll
                    for (int n = 0; n < 2; ++n) acc[a][b][m][n] = (f32x4){0.f, 0.f, 0.f, 0.f};
        cur = nxt; cA = nA; cB = nB; ++ui;
        if constexpr (ALIGN_EPI) { if (wr == 1) PG8_BAR; }
    }
    PG8_WAIT_V(0);
    if constexpr (!ALIGN_EPI) { if (wr == 0) PG8_BAR; }
    PG8_BAR;
    if constexpr (Epi::AFTER_DRAIN) { E.fused(acc, cur, wr, wc, fr, fq, lds, wid, lane); S.done(cur); }
#undef PG8_PRIO
#undef PG8_SA
#undef PG8_SB
#undef PG8_STAGE
#undef PG8_LDA
#undef PG8_LDB
#undef PG8_MMA
#undef PG8_WAIT_V
#undef PG8_WAIT_L
#undef PG8_BAR
#undef PG8_SCHED
}
}

namespace attn {
constexpr int D = 128, NW = 8, QBLK = 32, KVBLK = 64, QB = NW * QBLK;
constexpr int SHM_V = KVBLK * D * 2, SHM_K = KVBLK * D * 2;
constexpr int LDS_BYTES = 2 * SHM_V + 2 * SHM_K + NW * 64 * 4;
constexpr int KM_OFF = 69632;
constexpr float SCALE = 0.08838834764831845f, THR = 8.f;
typedef unsigned short bf16;
typedef short bf16x8 __attribute__((ext_vector_type(8)));
typedef short s16x4 __attribute__((ext_vector_type(4)));
typedef float f32x16 __attribute__((ext_vector_type(16)));
typedef float f32x4 __attribute__((ext_vector_type(4)));
typedef unsigned u32x4 __attribute__((ext_vector_type(4)));
#define KSWZ(row, colB) ((row) * 256 + ((colB) ^ (((row) & 7) << 4)))
#define SBAR() __builtin_amdgcn_sched_barrier(0)
__device__ __forceinline__ int v_st(int k, int c) { const int kk = (k & ~0xC) | ((k & 4) << 1) | ((k & 8) >> 1); return ((kk >> 3) * 4 + (c >> 5)) * 512 + ((kk & 7) * 32 + (c & 31)) * 2; }
__device__ __forceinline__ int v_rd_base(int lane) { return ((lane & 3) << 3) | (((lane >> 2) & 3) << 6) | (((lane >> 4) & 1) << 5) | (((lane >> 5) & 1) << 8); }
constexpr int v_rd_off(int d0, int ks, int half) { return d0 * 512 + ks * 4096 + half * 2048; }
__device__ __forceinline__ int crow(int r, int hi) { return (r & 3) + 8 * (r >> 2) + 4 * hi; }
__device__ __forceinline__ unsigned cvtpk(float lo, float hi) { unsigned r; asm volatile("v_cvt_pk_bf16_f32 %0, %1, %2" : "=v"(r) : "v"(lo), "v"(hi)); return r; }
__device__ __forceinline__ bf16x8 load8(const bf16* p) { return *reinterpret_cast<const bf16x8*>(p); }
__device__ __forceinline__ void moba_mask(f32x16& p0, f32x16& p1, int kb, int qm, int blk, unsigned selmask, float sr) {
    const float NEG = -__builtin_inff();
    const int n = kb >> 8, dq = qm - kb;
    const float base = -sr * (float)dq;
    if (n == blk) {
#pragma unroll
        for (int r = 0; r < 16; ++r) { const int c = (r & 3) + 8 * (r >> 2);
            p0[r] = (dq - c >= 0) ? fmaf(sr, (float)c, p0[r] + base) : NEG;
            p1[r] = (dq - c - 32 >= 0) ? fmaf(sr, (float)(c + 32), p1[r] + base) : NEG; }
    } else {
        const bool sel = ((selmask >> n) & 1u) != 0u;
#pragma unroll
        for (int r = 0; r < 16; ++r) { const int c = (r & 3) + 8 * (r >> 2);
            p0[r] = sel ? fmaf(sr, (float)c, p0[r] + base) : NEG;
            p1[r] = sel ? fmaf(sr, (float)(c + 32), p1[r] + base) : NEG; }
    }
}
__device__ __forceinline__ void partialSM(f32x16& p0, f32x16& p1, float& m_reg, float& mn, float& alpha) {
    float pmax = p0[0]; for (int r = 1; r < 16; ++r) pmax = fmaxf(pmax, p0[r]); for (int r = 0; r < 16; ++r) pmax = fmaxf(pmax, p1[r]);
    { auto rr = __builtin_amdgcn_permlane32_swap(__float_as_uint(pmax), __float_as_uint(pmax), false, false);
      pmax = fmaxf(__uint_as_float(rr[0]), __uint_as_float(rr[1])); }
    constexpr float C2 = 1.4426950408889634f * SCALE;
    if (__builtin_expect(__all((pmax - m_reg) * SCALE <= THR), 1)) { mn = m_reg; alpha = 1.f; }
    else { mn = fmaxf(m_reg, pmax); alpha = __builtin_amdgcn_exp2f((m_reg - mn) * C2); m_reg = mn; }
    const float mnL = -mn * C2;
    for (int r = 0; r < 16; ++r) p0[r] = fmaf(p0[r], C2, mnL); for (int r = 0; r < 16; ++r) p1[r] = fmaf(p1[r], C2, mnL);
    for (int r = 0; r < 16; ++r) p0[r] = __builtin_amdgcn_exp2f(p0[r]);
}
__device__ __forceinline__ void finishSM(f32x16& p0, f32x16& p1, float alpha, float& l_reg, bf16x8& pa0, bf16x8& pa1, bf16x8& pa2, bf16x8& pa3) {
    for (int r = 0; r < 16; ++r) p1[r] = __builtin_amdgcn_exp2f(p1[r]);
    float ps = 0; for (int r = 0; r < 16; ++r) ps += p0[r]; for (int r = 0; r < 16; ++r) ps += p1[r];
    { auto rr = __builtin_amdgcn_permlane32_swap(__float_as_uint(ps), __float_as_uint(ps), false, false);
      ps = __uint_as_float(rr[0]) + __uint_as_float(rr[1]); }
    l_reg = l_reg * alpha + ps;
#define PK4(P, B_, OUT) do { unsigned a0 = cvtpk(P[B_+0], P[B_+1]), a1 = cvtpk(P[B_+2], P[B_+3]);                          \
        unsigned b0 = cvtpk(P[B_+4], P[B_+5]), b1 = cvtpk(P[B_+6], P[B_+7]);                                             \
        auto r0 = __builtin_amdgcn_permlane32_swap(a0, b0, false, false); auto r1 = __builtin_amdgcn_permlane32_swap(a1, b1, false, false); \
        u32x4 w = {r0[0], r1[0], r0[1], r1[1]}; OUT = *reinterpret_cast<bf16x8*>(&w); } while (0)
    PK4(p0, 0, pa0); PK4(p0, 8, pa1); PK4(p1, 0, pa2); PK4(p1, 8, pa3);
#undef PK4
}
template <int KB>
__device__ __forceinline__ void qkt(f32x16& p0, f32x16& p1, const char* K_lds, int r32, int hi, const bf16x8* qr) {
    p0 = f32x16{}; p1 = f32x16{};
    const char* kb[4];
#pragma unroll
    for (int dd = 0; dd < 4; ++dd) kb[dd] = K_lds + KB * SHM_K + KSWZ(r32, (dd * 16 + hi * 8) * 2);
#pragma unroll
    for (int d0 = 0; d0 < 8; ++d0) { const char* a = kb[d0 & 3] + (d0 >> 2) * 128;
        bf16x8 b0 = *reinterpret_cast<const bf16x8*>(a);
        bf16x8 b1 = *reinterpret_cast<const bf16x8*>(a + 32 * 256);
        p0 = __builtin_amdgcn_mfma_f32_32x32x16_bf16(b0, qr[d0], p0, 0, 0, 0);
        p1 = __builtin_amdgcn_mfma_f32_32x32x16_bf16(b1, qr[d0], p1, 0, 0, 0); }
}
template <int VB>
__device__ __forceinline__ void pv_tile(f32x16* o, int vb0, bf16x8 pa0, bf16x8 pa1, bf16x8 pa2, bf16x8 pa3) {
#define TRRD(dst, off) asm volatile("ds_read_b64_tr_b16 %0, %1 offset:%2" : "=&v"(dst) : "v"(vb0), "i"(off) : "memory")
#define PV_D0(d0) do { s16x4 l0, l1, l2, l3, h0, h1, h2, h3; constexpr int b_ = VB * SHM_V + v_rd_off(d0, 0, 0); \
        TRRD(l0, b_); TRRD(h0, b_ + 2048); TRRD(l1, b_ + 4096); TRRD(h1, b_ + 6144); TRRD(l2, b_ + 8192); TRRD(h2, b_ + 10240); TRRD(l3, b_ + 12288); TRRD(h3, b_ + 14336); \
        asm volatile("s_waitcnt lgkmcnt(0)" ::: "memory"); SBAR();   \
        o[d0] = __builtin_amdgcn_mfma_f32_32x32x16_bf16(pa0, (bf16x8){l0[0], l0[1], l0[2], l0[3], h0[0], h0[1], h0[2], h0[3]}, o[d0], 0, 0, 0);   \
        o[d0] = __builtin_amdgcn_mfma_f32_32x32x16_bf16(pa1, (bf16x8){l1[0], l1[1], l1[2], l1[3], h1[0], h1[1], h1[2], h1[3]}, o[d0], 0, 0, 0);   \
        o[d0] = __builtin_amdgcn_mfma_f32_32x32x16_bf16(pa2, (bf16x8){l2[0], l2[1], l2[2], l2[3], h2[0], h2[1], h2[2], h2[3]}, o[d0], 0, 0, 0);   \
        o[d0] = __builtin_amdgcn_mfma_f32_32x32x16_bf16(pa3, (bf16x8){l3[0], l3[1], l3[2], l3[3], h3[0], h3[1], h3[2], h3[3]}, o[d0], 0, 0, 0); } while (0)
    PV_D0(0); PV_D0(1); PV_D0(2); PV_D0(3);
#undef PV_D0
#undef TRRD
}
struct BlockRef { const bf16* Q; const bf16* K; const bf16* V; bf16* O; int P0; };
struct Seam { bf16x8 qr[8]; bf16x8 st_v0, st_v1, st_k0, st_k1; };
constexpr int LDO = 2048;
#define ROW(p, k0, rr) ((p) + (size_t)((k0) + (rr)) * D + sc)
#define VMW() asm volatile("s_waitcnt vmcnt(0)" ::: "memory")
#define VMWN(n) asm volatile("s_waitcnt vmcnt(%0)" :: "i"(n) : "memory")
#define SLOAD_H(Kp, Vp, k0) do { S.st_v0 = load8(ROW(Vp, k0, sr_)); S.st_v1 = load8(ROW(Vp, k0, 32 + sr_));              \
                         S.st_k0 = load8(ROW(Kp, k0, sr_)); S.st_k1 = load8(ROW(Kp, k0, 32 + sr_)); } while (0)
#define SWRITE_HK(bf) do { *(bf16x8*)(K_lds + (bf) * SHM_K + kws) = S.st_k0; *(bf16x8*)(K_lds + (bf) * SHM_K + kws + 32 * 256) = S.st_k1; } while (0)
#define SWRITE_HV(bf) do { *(bf16x8*)(V_lds + (bf) * SHM_V + vst0) = S.st_v0; *(bf16x8*)(V_lds + (bf) * SHM_V + vst1) = S.st_v1; } while (0)
#define SWRITE_H(bf) do { SWRITE_HV(bf); SWRITE_HK(bf); } while (0)
__device__ __forceinline__ void moba_prime(const BlockRef& cur, char* lds, Seam& S, const int wid) {
    const int lane = lane_id_opaque(), tid = wid * 64 + lane, r32 = lane & 31, hi = lane >> 5;
    const int sr_ = tid >> 4, sc = (tid & 15) * 8, kws = KSWZ(sr_, sc * 2); char* K_lds = lds + 2 * SHM_V;
    for (int d0 = 0; d0 < 8; ++d0) S.qr[d0] = load8(cur.Q + (size_t)(wid * QBLK + r32) * D + d0 * 16 + hi * 8);
    SLOAD_H(cur.K, cur.V, 0); VMW(); SWRITE_HK(0);
    __syncthreads();
}
__device__ __forceinline__ void moba_block(const BlockRef& cur, const BlockRef& nxt, char* lds, Seam& S, int blk, float sr, const float* kmean_g, const int wid) {
    const int lane = lane_id_opaque(), tid = wid * 64 + lane, r32 = lane & 31, hi = lane >> 5;
    const int NT = cur.P0 / KVBLK + 4;
    const int qlo = cur.P0 + wid * QBLK, qm = qlo + r32 - 4 * hi;
    char* V_lds = lds; char* K_lds = lds + 2 * SHM_V;
    float* ws = (float*)(lds + 2 * SHM_V + 2 * SHM_K) + wid * 64; float* li_l = ws, * al_l = ws + 32;
    unsigned selmask = (1u << blk) - 1u;
#ifdef EXP_NOGATE
    if (blk > 3) selmask = 7u;
    if (false) {
#else
    if (blk > 3) {
#endif
        float* KM = (float*)(lds + KM_OFF);
        if (tid < 256) ((f32x4*)KM)[tid] = ((const f32x4*)kmean_g)[tid];
        __syncthreads();
        float g[7];
#pragma unroll
        for (int n = 0; n < 7; ++n) g[n] = -__builtin_inff();
#pragma unroll
        for (int n = 0; n < 7; ++n) {
            if (n < blk) {
                float a0 = 0.f, a1 = 0.f;
#pragma unroll
                for (int d0 = 0; d0 < 8; ++d0) {
                    const u32x4 qw = *reinterpret_cast<const u32x4*>(&S.qr[d0]);
                    const f32x4 k0 = *(const f32x4*)(KM + n * 128 + d0 * 16 + hi * 8), k1 = *(const f32x4*)(KM + n * 128 + d0 * 16 + hi * 8 + 4);
                    a0 = fmaf(__uint_as_float(qw[0] << 16), k0[0], a0); a1 = fmaf(__uint_as_float(qw[0] & 0xffff0000u), k0[1], a1);
                    a0 = fmaf(__uint_as_float(qw[1] << 16), k0[2], a0); a1 = fmaf(__uint_as_float(qw[1] & 0xffff0000u), k0[3], a1);
                    a0 = fmaf(__uint_as_float(qw[2] << 16), k1[0], a0); a1 = fmaf(__uint_as_float(qw[2] & 0xffff0000u), k1[1], a1);
                    a0 = fmaf(__uint_as_float(qw[3] << 16), k1[2], a0); a1 = fmaf(__uint_as_float(qw[3] & 0xffff0000u), k1[3], a1); }
                float a = a0 + a1;
                auto rr = __builtin_amdgcn_permlane32_swap(__float_as_uint(a), __float_as_uint(a), false, false);
                g[n] = __uint_as_float(rr[0]) + __uint_as_float(rr[1]);
            }
        }
        selmask = 0u;
#pragma unroll
        for (int n = 0; n < 7; ++n) {
            int rank = 0;
#pragma unroll
            for (int m2 = 0; m2 < 7; ++m2) { if (m2 != n) rank += (g[m2] > g[n] || (g[m2] == g[n] && m2 < n)) ? 1 : 0; }
            if (n < blk && rank < 3) selmask |= (1u << n);
        }
    }
    float m_reg = -1e30f, l_reg = 0; f32x16 o[4] = {};
    const int sr_ = tid >> 4, sc = (tid & 15) * 8, vst0 = v_st(sr_, sc), vst1 = v_st(32 + sr_, sc), kws = KSWZ(sr_, sc * 2);
    const int vb0 = (int)(uintptr_t)V_lds + v_rd_base(lane);
    const bf16* Kh = cur.K; const bf16* Vh = cur.V;
#define RESC(a) do { if (__any((a) < 1.f)) { if (hi == 0) al_l[r32] = (a); asm volatile("s_waitcnt lgkmcnt(0)" ::: "memory");              \
                     for (int d_ = 0; d_ < 4; ++d_) for (int r = 0; r < 16; ++r) o[d_][r] *= al_l[crow(r, hi)]; } } while (0)
#define KBASE(t) ((t) * KVBLK)
#define MASKT(P0_, P1_, t) moba_mask(P0_, P1_, KBASE(t), qm, blk, selmask, sr)
    constexpr int NQL = 8;
#define SEAM_K0() do { VMWN(NQL); SWRITE_HK(0); SBAR(); } while (0)
    f32x16 pA0, pA1, pB0, pB1; float mnA, mnB, alA, alB; bf16x8 pa0, pa1, pa2, pa3;
    SWRITE_HV(0); SBAR();
    if (NT > 1) { SLOAD_H(Kh, Vh, KBASE(1)); }
    SBAR(); qkt<0>(pA0, pA1, K_lds, r32, hi, S.qr);
    MASKT(pA0, pA1, 0); partialSM(pA0, pA1, m_reg, mnA, alA);
    if (NT > 1) { VMW(); SWRITE_H(1); }
    __syncthreads();
#define HALF_STEP(PX0, PX1, mnX, alX, PY0, PY1, alY, t, KB, VB, SB) do {                                                      \
        SBAR(); qkt<KB>(PX0, PX1, K_lds, r32, hi, S.qr);                                             \
        finishSM(PY0, PY1, alY, l_reg, pa0, pa1, pa2, pa3); SBAR();                                                           \
        if ((t) + 1 < NT) { SLOAD_H(Kh, Vh, KBASE((t) + 1)); SBAR(); }                                               \
        pv_tile<VB>(o, vb0, pa0, pa1, pa2, pa3); MASKT(PX0, PX1, (t)); partialSM(PX0, PX1, m_reg, mnX, alX);                                        \
        __syncthreads();                                                                                                      \
        if ((t) + 1 < NT) { VMW(); SWRITE_H(SB); }                                                                          \
        RESC(alX); __syncthreads(); } while (0)
    for (int t = 1; t + 1 < NT; t += 2) {
        HALF_STEP(pB0, pB1, mnB, alB, pA0, pA1, alA, t, 1, 0, 0);
        HALF_STEP(pA0, pA1, mnA, alA, pB0, pB1, alB, t + 1, 0, 1, 1);
    }
    const bool even = (NT & 1) == 0;
    if (even) { SBAR(); qkt<1>(pB0, pB1, K_lds, r32, hi, S.qr); SBAR(); }
    { SLOAD_H(nxt.K, nxt.V, 0); SBAR();
#pragma unroll
        for (int d0 = 0; d0 < 8; ++d0) S.qr[d0] = load8(nxt.Q + (size_t)(wid * QBLK + r32) * D + d0 * 16 + hi * 8); }
    SBAR();
    finishSM(pA0, pA1, alA, l_reg, pa0, pa1, pa2, pa3); SBAR();
    pv_tile<0>(o, vb0, pa0, pa1, pa2, pa3);
    if (even) { MASKT(pB0, pB1, NT - 1); partialSM(pB0, pB1, m_reg, mnB, alB); __syncthreads(); RESC(alB);
        finishSM(pB0, pB1, alB, l_reg, pa0, pa1, pa2, pa3); SBAR(); pv_tile<1>(o, vb0, pa0, pa1, pa2, pa3); }
    SBAR(); SEAM_K0();
    if (hi == 0) li_l[r32] = l_reg; asm volatile("s_waitcnt lgkmcnt(0)" ::: "memory");
    float rli[16];
#pragma unroll
    for (int r = 0; r < 16; ++r) rli[r] = __builtin_amdgcn_rcpf(li_l[crow(r, hi)]);
    bf16* Ow = cur.O + (size_t)(wid * QBLK) * LDO;
#pragma unroll
    for (int r = 0; r < 16; ++r) { const int orow = crow(r, hi);
#pragma unroll
        for (int d0 = 0; d0 < 4; ++d0) { const float v = o[d0][r] * rli[r];
            const float vn = dppx<0xB1>(v);
            if ((r32 & 1) == 0) *(unsigned*)(Ow + (size_t)orow * LDO + d0 * 32 + r32) = cvtpk(v, vn); } }
    __syncthreads();
#undef RESC
#undef KBASE
#undef MASKT
#undef SEAM_K0
#undef HALF_STEP
}
#undef ROW
#undef VMW
#undef VMWN
#undef SLOAD_H
#undef SWRITE_HK
#undef SWRITE_HV
#undef SWRITE_H
}

#define GAS __attribute__((address_space(1)))
#define LAS __attribute__((address_space(3)))
typedef unsigned short bf16;
typedef unsigned v4u __attribute__((ext_vector_type(4)));
typedef unsigned v2u __attribute__((ext_vector_type(2)));
typedef float f32x4 __attribute__((ext_vector_type(4)));
typedef float f32x2 __attribute__((ext_vector_type(2)));
typedef GAS unsigned gu32;
#define RLX_AGENT __ATOMIC_RELAXED, __HIP_MEMORY_SCOPE_AGENT
#define LDS_WAIT() asm volatile("s_waitcnt lgkmcnt(0)" ::: "memory")

constexpr int NWAVES = 8, NTHREADS = 512;
constexpr int BATCH = 8, SEQ = 2048, DM = 2048, M = BATCH * SEQ;
constexpr int NPROJ = 6656;
constexpr int DFF = 5632, NUP = 2 * DFF;
constexpr int KLORA = 384, NLORA = 4096;
constexpr int N_IN = 59;
constexpr float RMS_EPS = 1e-6f, GN_EPS = 64e-5f;

constexpr size_t MiB = 1u << 20;
constexpr size_t WS_CTL = 0, CTL_ZERO_BYTES = 2 * MiB;
constexpr size_t WS_RS = 2 * MiB;
constexpr size_t WS_WMIX = 8 * MiB, WS_WOUT = 34 * MiB, WS_WUP = 42 * MiB, WS_WDN = 86 * MiB, WS_WLORA = 108 * MiB;
constexpr size_t WS_XB = 112 * MiB;
constexpr size_t WS_VFIRST = 176 * MiB;
constexpr size_t WS_R0 = 208 * MiB;
constexpr size_t WS_U = WS_R0, WS_HALO = WS_R0, WS_ACT = WS_R0 + 352 * MiB;
constexpr size_t WS_PROJ = WS_R0, WS_QN = WS_R0 + 208 * MiB, WS_KN = WS_QN + 32 * MiB, WS_VV = WS_KN + 32 * MiB, WS_KMEAN = WS_VV + 32 * MiB,
                 WS_ZACT = WS_KMEAN + 1 * MiB, WS_SR = WS_ZACT + 12 * MiB, WS_SK = WS_SR + 32 * MiB, WS_SV = WS_SK + 32 * MiB, WS_SA = WS_SV + 32 * MiB,
                 WS_SB = WS_SA + 32 * MiB, WS_LD = WS_SB + 32 * MiB, WS_G = WS_LD + 64 * MiB, WS_YCAT = WS_G + 32 * MiB, WS_MIX_END = WS_YCAT + 64 * MiB;
constexpr size_t WS_H = WS_R0, WS_CV = WS_R0 + 208 * MiB, WS_HALO2 = WS_R0 + 272 * MiB, WS_MB = WS_R0 + 288 * MiB;
constexpr size_t WS_WALT = WS_R0 + 32 * MiB;
constexpr size_t WB_ODD = WS_WALT - WS_WMIX;
constexpr size_t WS_P0 = WS_SR, WS_P1 = WS_SV, WS_P2 = WS_SB, WS_P3 = WS_SB + 64 * MiB;
constexpr size_t WS_PCH = WS_MIX_END, WS_BON = WS_MIX_END + 4 * MiB;
constexpr size_t WS_END = WS_MIX_END + 5 * MiB;
static_assert(WS_ACT + (size_t)M * DFF * 2 <= WS_END && WS_MB + (size_t)M * DM * 2 <= WS_ACT && WS_WALT + 104 * MiB <= WS_CV && WS_R0 + 24 * MiB <= WS_WALT, "d_ws map");
constexpr int CW_BAR = 4096, CW_QUEUE = 8192, CW_DBG = 12288;
constexpr int RING_BYTES = 131072, XCH_OFF = RING_BYTES, MISC_OFF = RING_BYTES + 8192, TAP_OFF = RING_BYTES + 16384, LDS_BYTES = 155648;

#define XB_TMO      128
#define XB_XCNT(j)  (256  + 64 * (j))
#define XB_XSUB(j)  (1280 + 64 * (j))
#define XB_XGEN(j)  (2304 + 64 * (j))
#define XB_TOP      3328
#define XB_TOPGEN   3392
#define XCD_BAR_WORDS 3456
#define XB_SPIN_CAP (1u << 18)
__device__ __forceinline__ unsigned xb_ld(unsigned* p)              { return __hip_atomic_load(p, __ATOMIC_RELAXED, __HIP_MEMORY_SCOPE_AGENT); }
__device__ __forceinline__ unsigned xb_add(unsigned* p, unsigned v) { return __hip_atomic_fetch_add(p, v, __ATOMIC_RELAXED, __HIP_MEMORY_SCOPE_AGENT); }
__device__ __forceinline__ unsigned xb_xcc_id() { return (unsigned)__builtin_amdgcn_s_getreg((3 << 11) | 20) & 0xFu; }
#define XB_SPIN(cond, bar) do { unsigned _sp = 0; while (cond) { __builtin_amdgcn_s_sleep(1); \
    if ((++_sp & 255u) == 0u) { if (xb_ld(&(bar)[XB_TMO])) break; if (_sp > XB_SPIN_CAP) { atomicAdd(&(bar)[XB_TMO], 1u); break; } } } } while (0)
struct XcdBarrier { unsigned* bar; unsigned x; volatile LAS unsigned* st; };
__device__ __forceinline__ XcdBarrier xcd_barrier_post(unsigned* bar, volatile LAS unsigned* st) {
    XcdBarrier b; b.bar = bar; b.x = xb_xcc_id(); b.st = st;
    if (threadIdx.x == 0) (void)xb_add(&bar[XB_XCNT(b.x)], 1u);
    return b;
}
__device__ __forceinline__ void xcd_barrier_complete(unsigned* bar, unsigned x, unsigned& nloc, unsigned& nx) {
    const unsigned G = gridDim.x * gridDim.y * gridDim.z;
    unsigned sum, cnt, mine, sp = 0u;
    for (;;) {
        sum = 0u; cnt = 0u; mine = 0u;
#pragma unroll
        for (unsigned j = 0; j < 16; ++j) { const unsigned c = xb_ld(&bar[XB_XCNT(j)]); sum += c; cnt += (c > 0u) ? 1u : 0u; mine = (j == x) ? c : mine; }
        if (sum == G) break;
        __builtin_amdgcn_s_sleep(1);
        if ((++sp & 255u) == 0u) { if (xb_ld(&bar[XB_TMO])) break; if (sp > XB_SPIN_CAP) { atomicAdd(&bar[XB_TMO], 1u); break; } }
    }
    nloc = mine > 0u ? mine : 1u; nx = cnt > 0u ? cnt : 1u;
}
__device__ __forceinline__ void xcd_barrier(const XcdBarrier& b) {
    asm volatile("s_waitcnt vmcnt(0)" ::: "memory");
    __syncthreads();
    if (threadIdx.x == 0) {
        unsigned* bar = b.bar; unsigned bx = b.x;
        asm volatile("" : "+s"(bar), "+s"(bx));
        __builtin_amdgcn_s_waitcnt(0);
        unsigned nloc = b.st[0], nx = b.st[1];
        if (nloc == 0u) { xcd_barrier_complete(bar, bx, nloc, nx); b.st[0] = nloc; b.st[1] = nx; }
        const unsigned old = xb_add(&bar[XB_XSUB(bx)], 1u);
        const unsigned gen = old / nloc;
        if (old + 1u == (gen + 1u) * nloc) {
            __builtin_amdgcn_fence(__ATOMIC_RELEASE, "agent");
            asm volatile("s_waitcnt vmcnt(0)" ::: "memory");
            const unsigned og = xb_add(&bar[XB_TOP], 1u);
            const unsigned tgt = (og / nx + 1u) * nx;
            if (og + 1u != tgt) XB_SPIN(xb_ld(&bar[XB_TOP]) < tgt, bar);
            __builtin_amdgcn_fence(__ATOMIC_ACQUIRE, "agent");
            asm volatile("s_waitcnt vmcnt(0)" ::: "memory");
        } else {
            const unsigned tgt = (gen + 1u) * nx;
            XB_SPIN(xb_ld(&bar[XB_TOP]) < tgt, bar);
            __builtin_amdgcn_fence(__ATOMIC_ACQUIRE, "agent");
            asm volatile("s_waitcnt vmcnt(0)" ::: "memory");
        }
    }
    __syncthreads();
}

__device__ __forceinline__ unsigned pk2(float lo, float hi) { return pg8::cvt_pk_bf16(lo, hi); }
__device__ __forceinline__ float bflo(unsigned u) { return __uint_as_float(u << 16); }
__device__ __forceinline__ float bfhi(unsigned u) { return __uint_as_float(u & 0xffff0000u); }
template <int CTRL> __device__ __forceinline__ float dpp(float x) { return __builtin_bit_cast(float, __builtin_amdgcn_mov_dpp(__builtin_bit_cast(int, x), CTRL, 0xf, 0xf, true)); }
__device__ __forceinline__ float sum8(float x)  { x += dpp<0xB1>(x); x += dpp<0x4E>(x); x += dpp<0x141>(x); return x; }
__device__ __forceinline__ float sum16(float x) { x = sum8(x); x += dpp<0x128>(x); return x; }
__device__ __forceinline__ unsigned short bf1(float x) { return (unsigned short)(pk2(x, 0.f) & 0xffffu); }
__device__ __forceinline__ float sigm(float x) { return __builtin_amdgcn_rcpf(1.0f + __expf(-x)); }
__device__ __forceinline__ void unpack8(v4u w, float (&f)[8]) { f[0] = bflo(w.x); f[1] = bfhi(w.x); f[2] = bflo(w.y); f[3] = bfhi(w.y); f[4] = bflo(w.z); f[5] = bfhi(w.z); f[6] = bflo(w.w); f[7] = bfhi(w.w); }
__device__ __forceinline__ v4u pack8(const float (&f)[8]) { v4u w; w.x = pk2(f[0], f[1]); w.y = pk2(f[2], f[3]); w.z = pk2(f[4], f[5]); w.w = pk2(f[6], f[7]); return w; }

constexpr int CV_P = 129, CV_TILE = 64 * CV_P;
struct ConvP { const float *norm_mix, *w_mix, *w_out, *norm_ffn, *ffn_up, *ffn_down, *w_lora, *a_lora, *g_lora, *v_lora, *a0, *v0; };
struct CvItem { const float* W; const float* gain; bf16* WT; int ldw, K, nsrc, kb, drow0, scol0; };
__device__ __forceinline__ bool cv_decode(int it, const ConvP& P, int li, unsigned char* ws, CvItem& c, int bid_, int nwg_) {
    const bool even = (li & 1) == 0; if (!even) ws += WB_ODD;
    const int nsrc = even ? (li == 0 ? 6432 : 6464) : 6144, nb_mix = even ? NPROJ / 128 : 48;
    const int I_MIX = 32 * nb_mix, I_OUT = 32 * 16, I_UP = 32 * (NUP / 128), I_DN = (DFF / 64) * 16;
    int r = it;
    if (r < I_MIX) { c.W = P.w_mix; c.gain = P.norm_mix; c.WT = (bf16*)(ws + WS_WMIX); c.ldw = nsrc; c.K = DM; c.nsrc = nsrc; c.kb = r / nb_mix; const int nb = r % nb_mix; c.drow0 = 128 * nb; c.scol0 = even ? 128 * nb : (nb < 32 ? ((nb & 1) ? 4096 : 2048) + 128 * (nb >> 1) : 128 * (nb - 32)); return true; } r -= I_MIX;
    if (r < I_OUT) { c.W = P.w_out; c.gain = nullptr; c.WT = (bf16*)(ws + WS_WOUT); c.ldw = DM; c.K = DM; c.nsrc = DM; c.kb = r / 16; const int nb = r % 16; c.drow0 = 128 * nb; c.scol0 = 128 * nb; return true; } r -= I_OUT;
    if (r < I_UP) { const int nbu = NUP / 128, nb = r % nbu; c.W = P.ffn_up; c.gain = P.norm_ffn; c.WT = (bf16*)(ws + WS_WUP); c.ldw = NUP; c.K = DM; c.nsrc = NUP; c.kb = r / nbu; c.drow0 = 128 * nb;
        c.scol0 = (nb & 1) ? DFF + 128 * (nb >> 1) : 128 * (nb >> 1); return true; } r -= I_UP;
    if (r < I_DN) { c.W = P.ffn_down; c.gain = nullptr; c.WT = (bf16*)(ws + WS_WDN); c.ldw = DM; c.K = DFF; c.nsrc = DM; c.kb = r / 16; const int nb = r % 16; c.drow0 = 128 * nb; c.scol0 = 128 * nb; return true; }
    return false;
}
__device__ __forceinline__ void cv_load(const CvItem& c, int tid, f32x4 (&v)[4]) {
#pragma unroll
    for (int j = 0; j < 4; ++j) { const int i = tid + 512 * j, row = i >> 5, col = (i & 31) * 4;
        v[j] = (c.scol0 + col < c.nsrc) ? *(const f32x4*)(c.W + (size_t)(c.kb * 64 + row) * c.ldw + c.scol0 + col) : (f32x4){0.f, 0.f, 0.f, 0.f}; }
}
__device__ __forceinline__ void convert_layer(const ConvP P, int li, unsigned char* ws, LAS unsigned char* lds, int wave, int lane, int tid, int bid_, int nwg_, int it0, int it1, int step, bool do_lora) {
    LAS float* T = (LAS float*)lds;
    const bool even = (li & 1) == 0;
    CvItem cur, nxt; f32x4 v[4];
    int it = it0, buf = 0;
    bool have = it < it1 && cv_decode(it, P, li, ws, cur, bid_, nwg_);
    if (have) cv_load(cur, tid, v);
    while (have) {
        LAS float* t = T + buf * CV_TILE;
#pragma unroll
        for (int j = 0; j < 4; ++j) { const int i = tid + 512 * j, row = i >> 5, col = (i & 31) * 4; LAS float* p = t + row * CV_P + col; p[0] = v[j][0]; p[1] = v[j][1]; p[2] = v[j][2]; p[3] = v[j][3]; }
        LDS_WAIT(); __syncthreads();
        it += step;
        const bool hn = it < it1 && cv_decode(it, P, li, ws, nxt, bid_, nwg_);
        if (hn) cv_load(nxt, tid, v);
#pragma unroll
        for (int j = 0; j < 2; ++j) { const int q = tid + 512 * j, n = q >> 3, c = q & 7; const LAS float* s = t + (8 * c) * CV_P + n;
            float f[8];
#pragma unroll
            for (int e = 0; e < 8; ++e) f[e] = s[e * CV_P];
            if (cur.gain) { const f32x4 g0 = *(const f32x4*)(cur.gain + cur.kb * 64 + 8 * c), g1 = *(const f32x4*)(cur.gain + cur.kb * 64 + 8 * c + 4);
                f[0] *= g0[0]; f[1] *= g0[1]; f[2] *= g0[2]; f[3] *= g0[3]; f[4] *= g1[0]; f[5] *= g1[1]; f[6] *= g1[2]; f[7] *= g1[3]; }
            *(v4u*)(cur.WT + (size_t)(cur.drow0 + n) * cur.K + cur.kb * 64 + 8 * c) = pack8(f); }
        cur = nxt; have = hn; buf ^= 1;
    }
    __syncthreads();
    if (even && do_lora) {
        const int gt = bid_ * NTHREADS + tid, NGT = nwg_ * NTHREADS;
        bf16* Wlora = (bf16*)(ws + WS_WLORA);
        for (int i = gt; i < NLORA * (KLORA / 8); i += NGT) {
            const int row = i / (KLORA / 8), k8 = (i % (KLORA / 8)) * 8, h = row >> 8, c = row & 255;
            const int q = 2 * (c >> 7) + ((c >> 4) & 1), chn = 64 * h + 16 * ((c >> 5) & 3) + 4 * ((c >> 2) & 3) + (c & 3);
            const float* src = nullptr; int koff = 0;
            if (q == 0 && k8 < 64) { src = P.w_lora; koff = 0; }
            else if (q == 1 && k8 >= 64 && k8 < 128) { src = P.a_lora; koff = 64; }
            else if (q == 2 && k8 >= 128 && k8 < 288) { src = P.g_lora; koff = 128; }
            else if (q == 3 && k8 >= 288 && k8 < 320) { src = P.v_lora; koff = 288; }
            float f[8];
#pragma unroll
            for (int e = 0; e < 8; ++e) f[e] = src ? src[(size_t)(k8 - koff + e) * 1024 + chn] : 0.f;
            if (k8 == 320) { if (q == 1) f[0] = P.a0[chn]; else if (q == 3 && P.v0) f[0] = P.v0[chn]; }
            *(v4u*)(Wlora + (size_t)row * KLORA + k8) = pack8(f);
        }
    }
}

struct Args { const float* in[N_IN]; float* out; unsigned char* ws; int ph_lo, ph_hi; };
constexpr int PH_PER_LAYER = 9, N_PHASES = 1 + 4 * PH_PER_LAYER;

__device__ __forceinline__ void prologue_rows(const float* x, bf16* xb, float* rs0, int wave, int lane, int bid_, int nwg_) {
    const int gw = bid_ * NWAVES + wave, NGW = nwg_ * NWAVES;
    for (int m = gw; m < M; m += NGW) {
        const f32x4* xr = (const f32x4*)(x + (size_t)m * DM) + lane; float s = 0.f; f32x4 v[8];
#pragma unroll
        for (int j = 0; j < 8; ++j) { v[j] = xr[64 * j]; s += (v[j].x * v[j].x + v[j].y * v[j].y) + (v[j].z * v[j].z + v[j].w * v[j].w); }
        s = asum64(s);
        v2u* ob = (v2u*)(xb + (size_t)m * DM) + lane;
#pragma unroll
        for (int j = 0; j < 8; ++j) { v2u w; w.x = pk2(v[j].x, v[j].y); w.y = pk2(v[j].z, v[j].w); ob[64 * j] = w; }
        if (lane < 8) rs0[(size_t)m * 8 + lane] = lane == 0 ? s : 0.f;
    }
}

__device__ __forceinline__ void prep_phase(const float* q_gain, const float* k_gain, const float* shift_mu, bool has_v, unsigned char* ws, LAS unsigned char* lds, int wave, int lane, int tid, int bid_, int nwg_) {
    const bf16* proj = (const bf16*)(ws + WS_PROJ);
    bf16* QN = (bf16*)(ws + WS_QN); bf16* KN = (bf16*)(ws + WS_KN); bf16* VV = (bf16*)(ws + WS_VV); float* KMEAN = (float*)(ws + WS_KMEAN);
    {
        LAS float* red = (LAS float*)lds;
        const int c8 = (lane & 15) * 8, rsub = lane >> 4;
        for (int up = bid_; up < 256; up += nwg_) {
            const int unit = up * 2 + (wave >> 2);
            const bf16* kp = KN + ((size_t)(unit >> 3) * SEQ + (unit & 7) * 256 + (wave & 3) * 64 + rsub) * 128 + c8;
            v4u kw[16];
#pragma unroll
            for (int r = 0; r < 16; ++r) kw[r] = *(const v4u*)(kp + (size_t)r * 4 * 128);
            float kcol[8];
#pragma unroll
            for (int e = 0; e < 8; ++e) kcol[e] = 0.f;
#pragma unroll
            for (int r = 0; r < 16; ++r) { float kf[8]; unpack8(kw[r], kf);
#pragma unroll
                for (int e = 0; e < 8; ++e) kcol[e] += kf[e]; }
#pragma unroll
            for (int e = 0; e < 8; ++e) kcol[e] = xsum_rows4(kcol[e]);
            if (lane < 16) {
#pragma unroll
                for (int e = 0; e < 8; ++e) red[wave * 128 + c8 + e] = kcol[e]; }
            LDS_WAIT(); __syncthreads();
            if (tid < 256) { const int w4 = (tid >> 7) * 4, col = tid & 127;
                KMEAN[(size_t)(up * 2 + (tid >> 7)) * 128 + col] = ((red[w4 * 128 + col] + red[(w4 + 1) * 128 + col]) + (red[(w4 + 2) * 128 + col] + red[(w4 + 3) * 128 + col])) * (1.0f / 256.0f); }
            __syncthreads();
        }
    }
    bf16* ZACT = (bf16*)(ws + WS_ZACT);
    const int gt = bid_ * NTHREADS + tid, NGT = nwg_ * NTHREADS;
    for (int i0 = gt; i0 < M * 48; i0 += 6 * NGT) {
        v4u cw[6], pw[6];
#pragma unroll
        for (int q = 0; q < 6; ++q) { const int i = (i0 + q * NGT < M * 48) ? i0 + q * NGT : i0; const int tok = i / 48, k8 = (i % 48) * 8;
            const bf16* pr = proj + (size_t)tok * NPROJ + 6144 + k8;
            cw[q] = *(const v4u*)pr; pw[q] = *(const v4u*)((tok & (SEQ - 1)) ? pr - NPROJ : pr); }
#pragma unroll
        for (int q = 0; q < 6; ++q) { const int i = i0 + q * NGT; if (i >= M * 48) break; const int tok = i / 48, k8 = (i % 48) * 8;
            float f[8];
            if (k8 < 288 || (k8 < 320 && has_v)) {
                float c[8], p[8]; unpack8(cw[q], c);
                if ((tok & (SEQ - 1)) != 0) unpack8(pw[q], p); else {
#pragma unroll
                    for (int e = 0; e < 8; ++e) p[e] = 0.f; }
#pragma unroll
                for (int e = 0; e < 8; ++e) { const float mu = shift_mu[3072 + k8 + e]; const float z = c[e] + mu * (p[e] - c[e]);
                    float a = z;
                    if (k8 < 64) a = 1.0f - 2.0f * __builtin_amdgcn_rcpf(1.0f + __expf(2.0f * z));
                    else if (k8 >= 128 && k8 < 288) a = sigm(z);
                    f[e] = a; }
            } else {
#pragma unroll
                for (int e = 0; e < 8; ++e) f[e] = 0.f;
                if (k8 == 320) f[0] = 1.0f; }
            *(v4u*)(ZACT + (size_t)tok * KLORA + k8) = pack8(f);
        }
    }
}

#ifndef DUP_IMG
#define DUP_IMG 1
#endif
#ifndef DUP_Y
#define DUP_Y 1
#endif
constexpr int SCAN_TB = 16, SCAN_NC = SEQ / SCAN_TB;
constexpr int SC_XB = 0, SC_YB = SC_XB + 2 * 32 * 144, SC_SB = SC_YB + 2 * 32 * 144, SC_ZT = SC_SB + 64 * 144, SC_UVT = SC_ZT + 2 * 64 * 80, SC_AM = SC_UVT + 2 * 64 * 80,
              SC_G = SC_AM + 2 * 32 * 80, SC_H = SC_G + 2 * 32 * 36 * 4, SC_YO = SC_H + 32 * 65 * 4, SC_PC = SC_YO + 16 * 64 * 4, SC_VF = SC_PC + 2 * 256, SC_END = SC_VF + 2 * 16 * 64 * 4;
static_assert(SC_END <= RING_BYTES, "scan LDS map");
typedef short sbf16x8 __attribute__((ext_vector_type(8)));
typedef float f32x16 __attribute__((ext_vector_type(16)));
__device__ __forceinline__ void scan_chain(int b, int h, const float* gn_w, const float* gn_b, unsigned char* ws, LAS unsigned char* lds, const int wave) {
    const int lane = lane_id_opaque(), tid = wave * 64 + lane;
    LAS unsigned short* SBs = (LAS unsigned short*)(lds + SC_SB);
    LAS float* Hm = (LAS float*)(lds + SC_H);
    LAS float* YO = (LAS float*)(lds + SC_YO);
#define GM_(s)  ((LAS float*)(lds + SC_G + (s) * 4608))
#define XB_(s)  ((LAS unsigned short*)(lds + SC_XB + (s) * 4608))
#define YB_(s)  ((LAS unsigned short*)(lds + SC_YB + (s) * 4608))
#define ZT_(s)  ((LAS unsigned short*)(lds + SC_ZT + (s) * 5120))
#define UVT_(s) ((LAS unsigned short*)(lds + SC_UVT + (s) * 5120))
#define AM_(s)  ((LAS unsigned short*)(lds + SC_AM + (s) * 2560))
#define PC_(s)  ((LAS float*)(lds + SC_PC + (s) * 256))
#define VF_(s)  ((LAS float*)(lds + SC_VF + (s) * 4096))
    const int l31 = lane & 31, hh = lane >> 5;
    const int lt = tid >> 5, lc = (tid & 31) * 2;
    const unsigned cbase = (unsigned)b * (SEQ * 1024u) + 64u * h + lc;
    f32x16 S = {};
    for (int i = tid; i < 64 * 72 / 2; i += NTHREADS) ((LAS unsigned*)SBs)[i] = 0u;
    for (int i = tid; i < 2 * 32 * 40 / 2; i += NTHREADS) ((LAS unsigned*)(lds + SC_AM))[i] = 0u;
    v2u r0_, r1_, r2_, r3_; f32x2 rpc_ = (f32x2){0.f, 0.f}; float rbn_;
    unsigned qv0 = 0u, qg0 = 0u, qv1 = 0u, qg1 = 0u; float qb0 = 0.f, qb1 = 0.f;
#define SCAN_LOAD(c) do { const unsigned tk_ = (unsigned)b * SEQ + (unsigned)(c) * SCAN_TB + lt; const unsigned o_ = cbase + ((unsigned)(c) * SCAN_TB + lt) * 1024u; \
        r0_ = *(const v2u*)(ws + (unsigned)(WS_P0 + 4u * o_)); r1_ = *(const v2u*)(ws + (unsigned)(WS_P1 + 4u * o_)); r2_ = *(const v2u*)(ws + (unsigned)(WS_P2 + 4u * o_)); r3_ = *(const v2u*)(ws + (unsigned)(WS_P3 + 4u * o_)); \
        rbn_ = *(const float*)(ws + (unsigned)(WS_BON + 4u * (tk_ * 16u + h))); \
        if (lt == 0) rpc_ = *(const f32x2*)(ws + (unsigned)(WS_PCH + 4u * ((tk_ >> 4) * 1024u + 64u * h + lc))); } while (0)
#define LOW2(w) (((w).x & 0xffffu) | ((w).y << 16))
#define HIGH2(w) (((w).x >> 16) | ((w).y & 0xffff0000u))
#define SCAN_IMG(set) do { LAS unsigned short* zt_ = ZT_(set); LAS unsigned short* uv_ = UVT_(set); \
        *(LAS unsigned*)(XB_(set) + lt * 72 + lc) = LOW2(r0_); *(LAS unsigned*)(XB_(set) + (16 + lt) * 72 + lc) = HIGH2(r0_); \
        *(LAS unsigned*)(YB_(set) + lt * 72 + lc) = LOW2(r1_); *(LAS unsigned*)(YB_(set) + (16 + lt) * 72 + lc) = HIGH2(r1_); \
        const int sw = ((lc >> 4) & 3) << 3, j0 = lt ^ sw, j1 = (16 + lt) ^ sw; \
        zt_[lc * 40 + j0] = (unsigned short)(r2_.x & 0xffffu); zt_[(lc + 1) * 40 + j0] = (unsigned short)(r2_.y & 0xffffu); zt_[lc * 40 + j1] = (unsigned short)(r2_.x >> 16); zt_[(lc + 1) * 40 + j1] = (unsigned short)(r2_.y >> 16); \
        uv_[lc * 40 + j1] = (unsigned short)(r3_.x & 0xffffu); uv_[(lc + 1) * 40 + j1] = (unsigned short)(r3_.y & 0xffffu); \
        *(LAS f32x2*)(VF_(set) + lt * 64 + lc) = (f32x2){bflo(r3_.x), bflo(r3_.y)}; \
        if (lt == 0) *(LAS f32x2*)(PC_(set) + lc) = rpc_; \
        qv0 = qv1; qg0 = qg1; qb0 = qb1; qv1 = LOW2(r3_); qg1 = HIGH2(r3_); qb1 = rbn_; } while (0)
#define SCAN_G(set) do { f32x16 acc = {}; LAS unsigned short* am_ = AM_(set); LAS float* Gm = GM_(set); \
        _Pragma("unroll") for (int s = 0; s < 4; ++s) { const sbf16x8 A = *(const LAS sbf16x8*)(XB_(set) + l31 * 72 + 16 * s + 8 * hh), B = *(const LAS sbf16x8*)(YB_(set) + l31 * 72 + 16 * s + 8 * hh); \
            acc = __builtin_amdgcn_mfma_f32_32x32x16_bf16(A, B, acc, 0, 0, 0); } \
        const int j = l31 & 15; \
        _Pragma("unroll") for (int r = 0; r < 16; ++r) { const int t = (r & 3) + 8 * (r >> 2) + 4 * hh; \
            if (r < 8) { const float gv = (j < t) ? acc[r] : 0.f; Gm[t * 36 + l31] = gv; } else { const float av = (j <= t - 16) ? acc[r] : 0.f; am_[(t - 16) * 40 + l31] = bf1(av); } } } while (0)
    const float gw0 = gn_w[64 * h + lc], gw1 = gn_w[64 * h + lc + 1], gb0 = gn_b[64 * h + lc], gb1 = gn_b[64 * h + lc + 1];
    SCAN_LOAD(0);
#define SCAN_BAR() do { asm volatile("s_waitcnt lgkmcnt(0)" ::: "memory"); __builtin_amdgcn_s_barrier(); asm volatile("" ::: "memory"); } while (0)
    for (int bi = -1; bi < SCAN_NC; ++bi) {
        const int set = bi & 1, t0 = bi * SCAN_TB;
        if (bi >= 1) {
            const f32x2 yv = *(const LAS f32x2*)(YO + lt * 64 + lc);
            float sm = yv.x + yv.y;
            sm = asum32(sm);
            const float mean = sm * (1.0f / 64.0f), d0 = yv.x - mean, d1 = yv.y - mean;
            float vr = d0 * d0 + d1 * d1;
            vr = asum32(vr);
            const float rstd = rsqrtf(vr * (1.0f / 64.0f) + GN_EPS);
            const unsigned tok = (unsigned)b * SEQ + (t0 - SCAN_TB) + lt;
            const float o0 = (d0 * rstd * gw0 + gb0 + qb0 * bflo(qv0)) * bflo(qg0), o1 = (d1 * rstd * gw1 + gb1 + qb0 * bfhi(qv0)) * bfhi(qg0);
            *(unsigned*)(ws + (unsigned)(WS_YCAT + 2u * (tok * 2048u + 1024u + 64u * h + lc))) = pk2(o0, o1);
        }
        if (bi + 1 < SCAN_NC) { SCAN_IMG(set ^ 1); for (int di_ = 1; di_ < DUP_IMG; ++di_) { const unsigned a_ = qv0, b_ = qg0, c_ = qv1, e_ = qg1; const float f_ = qb0, g_ = qb1; SCAN_IMG(set ^ 1); qv0 = a_; qg0 = b_; qv1 = c_; qg1 = e_; qb0 = f_; qb1 = g_; } } else { qv0 = qv1; qg0 = qg1; qb0 = qb1; }
        if (bi + 2 < SCAN_NC) SCAN_LOAD(bi + 2);
        if (bi >= 0 && (wave == 1 || wave == 2)) {
            f32x16 acc = {};
#pragma unroll
            for (int s = 0; s < 4; ++s) { const sbf16x8 A = *(const LAS sbf16x8*)(XB_(set) + l31 * 72 + 16 * s + 8 * hh), B = *(const LAS sbf16x8*)(SBs + (32 * (wave - 1) + l31) * 72 + 16 * s + 8 * hh);
                acc = __builtin_amdgcn_mfma_f32_32x32x16_bf16(A, B, acc, 0, 0, 0); }
#pragma unroll
            for (int r = 0; r < 16; ++r) { const int t = (r & 3) + 8 * (r >> 2) + 4 * hh; Hm[t * 65 + 32 * (wave - 1) + l31] = acc[r]; }
        }
        SCAN_BAR();
        if (bi >= 0 && wave < 4) {
            const int vq = lane >> 4, t = lane & 15; const LAS float* Gm = GM_(set);
            f32x4 ga4[4], gk4[4]; float acc[4], vv[4];
#pragma unroll
            for (int q = 0; q < 4; ++q) { ga4[q] = *(const LAS f32x4*)(Gm + t * 36 + 4 * q); gk4[q] = *(const LAS f32x4*)(Gm + t * 36 + 16 + 4 * q); }
#pragma unroll
            for (int p = 0; p < 4; ++p) { const int v = 16 * wave + 4 * p + vq; acc[p] = Hm[t * 65 + v]; vv[p] = VF_(set)[t * 64 + v]; }
#define S3_STEP(j) do { const float gaj = ga4[(j) >> 2][(j) & 3], gkj = gk4[(j) >> 2][(j) & 3]; \
                _Pragma("unroll") for (int p = 0; p < 4; ++p) { const float uj = dppx<0x150 + (j)>(acc[p]), vj = dppx<0x150 + (j)>(vv[p]); acc[p] = fmaf(gaj, uj, fmaf(gkj, vj, acc[p])); } } while (0)
            S3_STEP(0); S3_STEP(1); S3_STEP(2); S3_STEP(3); S3_STEP(4); S3_STEP(5); S3_STEP(6); S3_STEP(7); S3_STEP(8); S3_STEP(9); S3_STEP(10); S3_STEP(11); S3_STEP(12); S3_STEP(13); S3_STEP(14);
#undef S3_STEP
#pragma unroll
            for (int p = 0; p < 4; ++p) { const int v = 16 * wave + 4 * p + vq; UVT_(set)[v * 40 + ((((t >> 3) ^ ((v >> 4) & 3))) << 3) + (t & 7)] = bf1(acc[p]); }
        } else if (wave == 6 && bi + 1 < SCAN_NC) { SCAN_G(set ^ 1); }
        SCAN_BAR();
        if (bi >= 0 && wave < 4) {
            const int vb = wave >> 1, kb = wave & 1; const float pc = PC_(set)[32 * kb + l31];
            f32x16 acc = {};
#pragma unroll
            for (int s = 0; s < 2; ++s) { const int swr = ((l31 >> 4) & 1) << 3; const sbf16x8 A = *(const LAS sbf16x8*)(UVT_(set) + (32 * vb + l31) * 40 + ((16 * s + 8 * hh) ^ (swr | (vb << 4)))), B = *(const LAS sbf16x8*)(ZT_(set) + (32 * kb + l31) * 40 + ((16 * s + 8 * hh) ^ (swr | (kb << 4))));
                acc = __builtin_amdgcn_mfma_f32_32x32x16_bf16(A, B, acc, 0, 0, 0); }
            acc = S * pc + acc; S = acc;
#pragma unroll
            for (int r = 0; r < 16; ++r) { const int v = 32 * vb + (r & 3) + 8 * (r >> 2) + 4 * hh; SBs[v * 72 + 32 * kb + l31] = bf1(acc[r]); }
        } else for (int dy_ = 0; dy_ < DUP_Y; ++dy_) if (bi >= 0 && wave < 6) {
            f32x16 acc = {};
#pragma unroll
            for (int s = 0; s < 2; ++s) { const int swr = (((l31 >> 4) & 1) | ((wave - 4) << 1)) << 3; const sbf16x8 A = *(const LAS sbf16x8*)(AM_(set) + l31 * 40 + 16 * s + 8 * hh), B = *(const LAS sbf16x8*)(UVT_(set) + (32 * (wave - 4) + l31) * 40 + ((16 * s + 8 * hh) ^ swr));
                acc = __builtin_amdgcn_mfma_f32_32x32x16_bf16(A, B, acc, 0, 0, 0); }
            float hv_[8];
#pragma unroll
            for (int r = 0; r < 8; ++r) { const int t = (r & 3) + 8 * (r >> 2) + 4 * hh; hv_[r] = Hm[(16 + t) * 65 + 32 * (wave - 4) + l31]; }
#pragma unroll
            for (int r = 0; r < 8; ++r) { const int t = (r & 3) + 8 * (r >> 2) + 4 * hh; const int v = 32 * (wave - 4) + l31; YO[t * 64 + v] = acc[r] + hv_[r]; }
        }
        SCAN_BAR();
    }
    {
        const f32x2 yv = *(const LAS f32x2*)(YO + lt * 64 + lc);
        float sm = yv.x + yv.y; sm = asum32(sm);
        const float mean = sm * (1.0f / 64.0f), d0 = yv.x - mean, d1 = yv.y - mean;
        float vr = d0 * d0 + d1 * d1; vr = asum32(vr);
        const float rstd = rsqrtf(vr * (1.0f / 64.0f) + GN_EPS);
        const unsigned tok = (unsigned)b * SEQ + (SCAN_NC - 1) * SCAN_TB + lt;
        const float o0 = (d0 * rstd * gw0 + gb0 + qb0 * bflo(qv0)) * bflo(qg0), o1 = (d1 * rstd * gw1 + gb1 + qb0 * bfhi(qv0)) * bfhi(qg0);
        *(unsigned*)(ws + (unsigned)(WS_YCAT + 2u * (tok * 2048u + 1024u + 64u * h + lc))) = pk2(o0, o1);
    }
    LDS_WAIT(); __syncthreads();
#undef SCAN_BAR
#undef SCAN_LOAD
#undef SCAN_IMG
#undef SCAN_G
#undef LOW2
#undef HIGH2
#undef GM_
#undef XB_
#undef YB_
#undef ZT_
#undef UVT_
#undef AM_
#undef PC_
#undef VF_
}

__device__ __forceinline__ void conv_fix_phase(const float* ffn_conv, unsigned char* ws, int tid, int bid_, int nwg_) {
    const bf16* HALO = (const bf16*)(ws + WS_HALO); bf16* ACT = (bf16*)(ws + WS_ACT);
    const int gt = bid_ * NTHREADS + tid, NGT = nwg_ * NTHREADS;
    constexpr int NG = DFF / 8, NT = (M / 64) * NG;
    for (int task = gt; task < NT; task += 2 * NGT) {
        v4u hw[2][8];
        const int task1 = task + NGT; const bool two = task1 < NT;
#pragma unroll
        for (int q = 0; q < 2; ++q) { const int tk = q ? (two ? task1 : task) : task;
            const int g8 = tk % NG, sg = tk / NG, ch = g8 * 8, gcol = 256 * (ch >> 7) + (ch & 127);
            const bf16* hc = HALO + (size_t)sg * 4 * NUP + gcol; const bf16* hp = ((sg * 64) & (SEQ - 1)) ? hc - 4 * NUP : hc;
            hw[q][0] = *(const v4u*)(hp + 2 * NUP); hw[q][1] = *(const v4u*)(hp + 2 * NUP + 128); hw[q][2] = *(const v4u*)(hp + 3 * NUP); hw[q][3] = *(const v4u*)(hp + 3 * NUP + 128);
            hw[q][4] = *(const v4u*)(hc); hw[q][5] = *(const v4u*)(hc + 128); hw[q][6] = *(const v4u*)(hc + NUP); hw[q][7] = *(const v4u*)(hc + NUP + 128); }
#pragma unroll
        for (int q = 0; q < 2; ++q) { if (q == 1 && !two) break; const int tk = q ? task1 : task;
            const int g8 = tk % NG, sg = tk / NG, t0 = sg * 64, ch = g8 * 8;
            float g[4][8], v[4][8];
            unpack8(hw[q][4], g[2]); unpack8(hw[q][5], v[2]); unpack8(hw[q][6], g[3]); unpack8(hw[q][7], v[3]);
            if ((t0 & (SEQ - 1)) != 0) { unpack8(hw[q][0], g[0]); unpack8(hw[q][1], v[0]); unpack8(hw[q][2], g[1]); unpack8(hw[q][3], v[1]); }
            else {
#pragma unroll
                for (int e = 0; e < 8; ++e) { g[0][e] = 0.f; g[1][e] = 0.f; v[0][e] = 0.f; v[1][e] = 0.f; } }
            float o0[8], o1[8];
#pragma unroll
            for (int e = 0; e < 8; ++e) { const float a0 = ffn_conv[ch + e], a1 = ffn_conv[NUP + ch + e], a2 = ffn_conv[2 * NUP + ch + e], b0 = ffn_conv[DFF + ch + e], b1 = ffn_conv[NUP + DFF + ch + e], b2 = ffn_conv[2 * NUP + DFF + ch + e];
                const float cg0 = a0 * g[0][e] + a1 * g[1][e] + a2 * g[2][e], cv0 = b0 * v[0][e] + b1 * v[1][e] + b2 * v[2][e];
                const float cg1 = a0 * g[1][e] + a1 * g[2][e] + a2 * g[3][e], cv1 = b0 * v[1][e] + b1 * v[2][e] + b2 * v[3][e];
                o0[e] = cg0 * sigm(cg0) * cv0; o1[e] = cg1 * sigm(cg1) * cv1; }
            *(v4u*)(ACT + (size_t)t0 * DFF + ch) = pack8(o0); *(v4u*)(ACT + (size_t)(t0 + 1) * DFF + ch) = pack8(o1);
        }
    }
}
__device__ __forceinline__ void conv_fix2_phase(const float* conv_w, unsigned char* ws, int tid, int bid_, int nwg_) {
    const bf16* HALO = (const bf16*)(ws + WS_HALO2); bf16* CV = (bf16*)(ws + WS_CV);
    const int gt = bid_ * NTHREADS + tid, NGT = nwg_ * NTHREADS;
    constexpr int NG = DM / 8;
    for (int task = gt; task < (M / 64) * NG; task += NGT) {
        const int g8 = task % NG, sg = task / NG, t0 = sg * 64, ch = g8 * 8;
        float c[4][8];
        const bf16* hc = HALO + (size_t)sg * 4 * DM + ch;
        unpack8(*(const v4u*)(hc), c[2]); unpack8(*(const v4u*)(hc + DM), c[3]);
        if ((t0 & (SEQ - 1)) != 0) { unpack8(*(const v4u*)(hc - 2 * DM), c[0]); unpack8(*(const v4u*)(hc - DM), c[1]); }
        else {
#pragma unroll
            for (int e = 0; e < 8; ++e) { c[0][e] = 0.f; c[1][e] = 0.f; } }
        float o0[8], o1[8];
#pragma unroll
        for (int e = 0; e < 8; ++e) { const float a0 = conv_w[ch + e], a1 = conv_w[DM + ch + e], a2 = conv_w[2 * DM + ch + e];
            o0[e] = a0 * c[0][e] + a1 * c[1][e] + a2 * c[2][e]; o1[e] = a0 * c[1][e] + a1 * c[2][e] + a2 * c[3][e]; }
        *(v4u*)(CV + (size_t)t0 * DM + ch) = pack8(o0); *(v4u*)(CV + (size_t)(t0 + 1) * DM + ch) = pack8(o1);
    }
}
__device__ __forceinline__ void conv_mix_phase(const float* conv_w, unsigned char* ws, int tid, int bid_, int nwg_) {
    const bf16* H = (const bf16*)(ws + WS_H); bf16* MB = (bf16*)(ws + WS_MB);
    const int gt = bid_ * NTHREADS + tid, NGT = nwg_ * NTHREADS;
    constexpr int RUN = 32, NG = DM / 8;
    for (int task = gt; task < (M / RUN) * NG; task += NGT) {
        const int g8 = task % NG, t0 = (task / NG) * RUN, ch = g8 * 8;
        float w[3][8];
#pragma unroll
        for (int j = 0; j < 3; ++j)
#pragma unroll
            for (int e = 0; e < 8; ++e) w[j][e] = conv_w[j * DM + ch + e];
        float c1[8], c2[8];
#pragma unroll
        for (int e = 0; e < 8; ++e) { c1[e] = 0.f; c2[e] = 0.f; }
        const bf16* hp = H + (size_t)t0 * 6144 + ch;
        if ((t0 & (SEQ - 1)) != 0) { float a[8], u[8]; unpack8(*(const v4u*)(hp - 6144 + 2048), a); unpack8(*(const v4u*)(hp - 6144 + 4096), u);
#pragma unroll
            for (int e = 0; e < 8; ++e) c1[e] = a[e] * u[e];
            unpack8(*(const v4u*)(hp - 2 * 6144 + 2048), a); unpack8(*(const v4u*)(hp - 2 * 6144 + 4096), u);
#pragma unroll
            for (int e = 0; e < 8; ++e) c2[e] = a[e] * u[e]; }
        for (int r = 0; r < RUN; ++r) {
            float gb[8], a[8], u[8], o[8]; const bf16* q = hp + (size_t)r * 6144;
            unpack8(*(const v4u*)q, gb); unpack8(*(const v4u*)(q + 2048), a); unpack8(*(const v4u*)(q + 4096), u);
#pragma unroll
            for (int e = 0; e < 8; ++e) { const float c0 = a[e] * u[e]; o[e] = gb[e] * (w[0][e] * c2[e] + w[1][e] * c1[e] + w[2][e] * c0); c2[e] = c1[e]; c1[e] = c0; }
            *(v4u*)(MB + (size_t)(t0 + r) * DM + ch) = pack8(o);
        }
    }
}

__global__ void __launch_bounds__(NTHREADS, 2) mk_fwd(Args args) {
    extern __shared__ __attribute__((aligned(16))) unsigned char lds_raw[];
    LAS unsigned char* lds = (LAS unsigned char*)lds_raw;
    volatile LAS unsigned* MISC = (volatile LAS unsigned*)(lds + MISC_OFF);
    const int tid0 = threadIdx.x, wave0 = __builtin_amdgcn_readfirstlane(tid0 >> 6);
    unsigned char* ws = args.ws;
    gu32* ctl = (gu32*)(ws + WS_CTL);
    for (int u = tid0; u < 64; u += NTHREADS) MISC[u] = 0u;
    __syncthreads();
    XcdBarrier bar = xcd_barrier_post((unsigned*)ctl + CW_BAR, MISC + 8);
    const int lo = args.ph_lo, hi = args.ph_hi;
#define IN(k) (lo <= (k) && (k) < hi)
#define SEAM(k) do { if ((k) + 1 < hi) { for (int rb_ = 0; rb_ < REP_BAR; ++rb_) xcd_barrier(bar); } } while (0)
    bf16* XB = (bf16*)(ws + WS_XB);
    float* RS = (float*)(ws + WS_RS);

#ifndef DUP_ATT
#define DUP_ATT 1
#endif
#ifndef REP_UP
#define REP_UP 1
#endif
#ifndef REP_CS
#define REP_CS 1
#endif
#ifndef REP_AS
#define REP_AS 1
#endif
#ifndef REP_CV
#define REP_CV 1
#endif
#ifndef REP_PR
#define REP_PR 1
#endif
#ifndef REP_LO
#define REP_LO 1
#endif
#ifndef REP_DN
#define REP_DN 1
#endif
#ifndef XG_MO
#define XG_MO 0
#endif
#ifndef REP_MO
#define REP_MO 1
#endif
#ifndef REP_GB
#define REP_GB 1
#endif
#ifndef REP_MX
#define REP_MX 1
#endif
#ifndef REP_BAR
#define REP_BAR 1
#endif
#ifndef MK_PHASES
#define MK_PHASES 0xfff
#endif
#define PH_ON(k) (((MK_PHASES) >> (k)) & 1)
#define LB(l) ((l) == 0 ? 1 : (l) == 1 ? 21 : (l) == 2 ? 29 : 51)
#define FO(l) (((l) & 1) ? 4 : ((l) == 0 ? 16 : 18))
#define OO(l) (((l) & 1) ? 3 : 15)
    for (int li = 0; li < 4; ++li) {
        const bool even = (li & 1) == 0;
        const int pb = 1 + PH_PER_LAYER * li, lb = LB(li);
        unsigned char* wsw = ws + (even ? (size_t)0 : WB_ODD);
#if PH_ON(9)
        if (li == 0 && IN(0)) { const int wave = opq_s(wave0), bid = opq_s((int)blockIdx.x), nwg = opq_s((int)gridDim.x); (void)bid; (void)nwg;
            const int lane = lane_id_opaque(), tid = wave * 64 + lane;
            prologue_rows(args.in[0], XB, RS, wave, lane, bid, nwg);
            const ConvP C{args.in[1], args.in[2], args.in[16], args.in[17], args.in[18], args.in[20], args.in[7], args.in[9], args.in[10], nullptr, args.in[8], nullptr};
            convert_layer(C, 0, ws, lds, wave, lane, tid, bid, nwg, bid, 32 * (NPROJ / 128), nwg, true);
            SEAM(0);
        }
#endif
#if PH_ON(0)
        if (IN(pb + 0)) { const int wave = opq_s(wave0), bid = opq_s((int)blockIdx.x), nwg = opq_s((int)gridDim.x); (void)bid; (void)nwg;
            if (even) {
                pg8::Gemm g{XB, (const bf16*)(wsw + WS_WMIX), M, NPROJ, DM}; pg8::StaticOrder S; S.init(M, NPROJ, nwg, bid);
                pg8::EpiProj E{(bf16*)(ws + WS_R0), RS + (size_t)(2 * li) * M * 8, args.in[lb + 2], args.in[lb + 3], (bf16*)(ws + WS_QN), (bf16*)(ws + WS_KN), (bf16*)(ws + WS_VV), (float*)(ws + WS_KMEAN),
                               (LAS float*)(lds + XCH_OFF), (LAS float*)(lds + MISC_OFF + 1024)};
                for (int rep = 0; rep < REP_MX; ++rep)
                pg8::gemm_phase<pg8::EpiProj, pg8::StaticOrder, true, true>(lds, g, S, E, wave);
                const bool half_ = (nwg == 256);
                if (!half_ || bid >= 128) {
                    const int fo = FO(li);
                    const ConvP C{args.in[lb], args.in[lb + 1], args.in[lb + OO(li)], args.in[lb + fo], args.in[lb + fo + 1], args.in[lb + fo + 3], nullptr, nullptr, nullptr, nullptr, nullptr, nullptr};
                    const int lane_ = lane_id_opaque();
                    convert_layer(C, li, ws, lds, wave, lane_, wave * 64 + lane_, bid, nwg, 32 * (NPROJ / 128) + (half_ ? bid - 128 : bid), 0x7fffffff, half_ ? 128 : nwg, false);
                }
            } else {
                pg8::Gemm g{XB, (const bf16*)(wsw + WS_WMIX), M, 4096, DM}; pg8::StaticOrder S; S.init(M, 4096, nwg, bid);
                pg8::EpiCU E{(bf16*)(ws + WS_CV), (bf16*)(ws + WS_HALO2), RS + (size_t)(2 * li) * M * 8, (LAS float*)(lds + MISC_OFF + 1024), args.in[lb + 2], (LAS float*)(lds + TAP_OFF)};
#if XG_MO
                { pg8::EpiNull EN; pg8::gemm_phase<pg8::EpiNull, pg8::StaticOrder, true, true>(lds, g, S, EN, wave); }
#endif
                for (int rep = 0; rep < REP_MO; ++rep)
                pg8::gemm_phase<pg8::EpiCU, pg8::StaticOrder, true, true>(lds, g, S, E, wave);
            }
            SEAM(pb + 0);
        }
#endif
#if PH_ON(1)
        if (IN(pb + 1)) { const int wave = opq_s(wave0), bid = opq_s((int)blockIdx.x), nwg = opq_s((int)gridDim.x); (void)bid; (void)nwg;
            const int lane = lane_id_opaque(), tid = wave * 64 + lane;
            for (int rep = 0; rep < REP_PR; ++rep)
            if (even) prep_phase(args.in[lb + 2], args.in[lb + 3], args.in[lb + 4], li != 0, ws, lds, wave, lane, tid, bid, nwg);
            else conv_fix2_phase(args.in[lb + 2], ws, tid, bid, nwg);
            SEAM(pb + 1);
        }
#endif
#if PH_ON(2)
        if (even && IN(pb + 2)) { const int wave = opq_s(wave0), bid = opq_s((int)blockIdx.x), nwg = opq_s((int)gridDim.x); (void)bid; (void)nwg;
            pg8::Gemm g{(const bf16*)(ws + WS_ZACT), (const bf16*)(ws + WS_WLORA), M, NLORA, KLORA}; pg8::StaticOrder S; S.init(M, NLORA, nwg, bid);
            pg8::EpiLora E{(const bf16*)(ws + WS_PROJ), args.in[lb + 4], args.in[lb + 5], args.in[lb + 7], li == 0 ? (const float*)nullptr : args.in[45], args.in[lb + 10], args.in[lb + 11], args.in[lb + 12], (bf16*)(ws + WS_VFIRST),
                           (unsigned*)(ws + WS_P0), (unsigned*)(ws + WS_P1), (unsigned*)(ws + WS_P2), (unsigned*)(ws + WS_P3), (float*)(ws + WS_PCH), (float*)(ws + WS_BON), (LAS float*)(lds + XCH_OFF)};
            for (int rep = 0; rep < REP_LO; ++rep) { if (rep > 0) xcd_barrier(bar);
            pg8::gemm_phase<pg8::EpiLora, pg8::StaticOrder, true, true>(lds, g, S, E, wave); }
            SEAM(pb + 2);
        }
#endif
#if PH_ON(2)
        if (!even && IN(pb + 2)) { const int wave = opq_s(wave0), bid = opq_s((int)blockIdx.x), nwg = opq_s((int)gridDim.x); (void)bid; (void)nwg;
            pg8::Gemm g{XB, (const bf16*)(wsw + WS_WMIX) + (size_t)4096 * DM, M, DM, DM}; pg8::StaticOrder S; S.init(M, DM, nwg, bid);
            pg8::EpiGateB E{(bf16*)(ws + WS_MB), (const bf16*)(ws + WS_CV), RS + (size_t)(2 * li) * M * 8, (LAS float*)(lds + MISC_OFF + 1024)};
            for (int rep = 0; rep < REP_GB; ++rep)
            pg8::gemm_phase<pg8::EpiGateB, pg8::StaticOrder, true, true>(lds, g, S, E, wave);
            SEAM(pb + 2);
        }
#endif
#if PH_ON(3)
        if (even && IN(pb + 3)) { const int wave = opq_s(wave0), bid = opq_s((int)blockIdx.x), nwg = opq_s((int)gridDim.x); (void)bid; (void)nwg;
            for (int rep = 0; rep < REP_AS; ++rep) {
            if (rep > 0) xcd_barrier(bar);
            gu32* qctr = ctl + CW_QUEUE + 64 * (li + 4 * rep);
#ifdef EXP_STATIC
            for (int item = 128 + (int)blockIdx.x; item < 640; item += (int)gridDim.x) {
#else
            for (;;) {
                if (threadIdx.x == 0) MISC[12] = __hip_atomic_fetch_add(qctr, 1u, RLX_AGENT);
                __syncthreads();
                const int item = (int)MISC[12];
                __syncthreads();
                if (item >= 640 + 896) break;
                if (item >= 640) {
                    const int ln = li + 1, nb = LB(ln), fo = FO(ln), cb = item - 640;
                    const ConvP C{args.in[nb], args.in[nb + 1], args.in[nb + OO(ln)], args.in[nb + fo], args.in[nb + fo + 1], args.in[nb + fo + 3], nullptr, nullptr, nullptr, nullptr, nullptr, nullptr};
                    const int lane_ = lane_id_opaque();
                    convert_layer(C, ln, ws, lds, wave, lane_, wave * 64 + lane_, bid, nwg, 7 * cb, 7 * cb + 7, 1, false);
                    continue;
                }
#endif
                if (item < 128) {
#if PH_ON(10)
#if defined(SCAN_CHK) && SCAN_CHK == 5
                    scan_chain_seq(item >> 4, item & 15, args.in[lb + 12], args.in[lb + 13], args.in[lb + 14], ws, lds, wave);
                    __syncthreads();
#endif
                    scan_chain(item >> 4, item & 15, args.in[lb + 13], args.in[lb + 14], ws, lds, wave);
#endif
                } else {
#if PH_ON(11)
                    const int j = item - 128, blk = 7 - (j >> 6), bh = j & 63, b = bh >> 3, h = bh & 7;
                    const size_t hb = ((size_t)b * 8 + h) * SEQ * 128;
                    attn::BlockRef cur;
                    cur.Q = (const bf16*)(ws + WS_QN) + hb + (size_t)blk * 256 * 128; cur.K = (const bf16*)(ws + WS_KN) + hb; cur.V = (const bf16*)(ws + WS_VV) + hb;
                    cur.O = (bf16*)(ws + WS_YCAT) + ((size_t)b * SEQ + blk * 256) * 2048 + h * 128; cur.P0 = blk * 256;
                    for (int da_ = 0; da_ < DUP_ATT; ++da_) {
                    attn::Seam Sm;
                    attn::moba_prime(cur, (char*)lds_raw, Sm, wave);
                    const float slope = exp2f(-(float)(h + 1));
                    attn::moba_block(cur, cur, (char*)lds_raw, Sm, blk, slope * (1.0f / attn::SCALE), (const float*)(ws + WS_KMEAN) + ((size_t)b * 8 + h) * 1024, wave);
                    }
#endif
                }
            }
            }
            SEAM(pb + 3);
        }
#endif
#if PH_ON(4)
        if (IN(pb + 4)) { const int wave = opq_s(wave0), bid = opq_s((int)blockIdx.x), nwg = opq_s((int)gridDim.x); (void)bid; (void)nwg;
            pg8::Gemm g{even ? (const bf16*)(ws + WS_YCAT) : (const bf16*)(ws + WS_MB), (const bf16*)(wsw + WS_WOUT), M, DM, DM}; pg8::StaticOrder S; S.init(M, DM, nwg, bid);
            pg8::EpiResid E{nullptr, XB, RS + (size_t)(2 * li + 1) * M * 8, (LAS float*)(lds + XCH_OFF)};
            pg8::gemm_phase<pg8::EpiResid, pg8::StaticOrder, true, true>(lds, g, S, E, wave);
            SEAM(pb + 4);
        }
#endif
#if PH_ON(5)
        if (IN(pb + 5)) { const int wave = opq_s(wave0), bid = opq_s((int)blockIdx.x), nwg = opq_s((int)gridDim.x); (void)bid; (void)nwg;
            pg8::Gemm g{XB, (const bf16*)(wsw + WS_WUP), M, NUP, DM}; pg8::StaticOrder S; S.init(M, NUP, nwg, bid);
            pg8::EpiUpConv E{(bf16*)(ws + WS_ACT), (bf16*)(ws + WS_HALO), RS + (size_t)(2 * li + 1) * M * 8, (LAS float*)(lds + MISC_OFF + 1024), args.in[lb + FO(li) + 2], (LAS float*)(lds + TAP_OFF)};
            for (int rep = 0; rep < REP_UP; ++rep)
            pg8::gemm_phase<pg8::EpiUpConv, pg8::StaticOrder, true, true>(lds, g, S, E, wave);
            SEAM(pb + 5);
        }
#endif
#if PH_ON(6)
        if (IN(pb + 6)) { const int wave = opq_s(wave0), bid = opq_s((int)blockIdx.x), nwg = opq_s((int)gridDim.x); (void)bid; (void)nwg; const int tid = wave * 64 + lane_id_opaque(); for (int rep = 0; rep < REP_CS; ++rep) conv_fix_phase(args.in[lb + FO(li) + 2], ws, tid, bid, nwg); SEAM(pb + 6); }
#endif
#if PH_ON(7)
        if (IN(pb + 7)) { const int wave = opq_s(wave0), bid = opq_s((int)blockIdx.x), nwg = opq_s((int)gridDim.x); (void)bid; (void)nwg;
            pg8::Gemm g{(const bf16*)(ws + WS_ACT), (const bf16*)(wsw + WS_WDN), M, DM, DFF}; pg8::StaticOrder S; S.init(M, DM, nwg, bid);
            pg8::EpiResid E{li == 3 ? args.out : (float*)nullptr, XB, RS + (size_t)(2 * li + 2) * M * 8, (LAS float*)(lds + XCH_OFF)};
            pg8::gemm_phase<pg8::EpiResid, pg8::StaticOrder, true, true>(lds, g, S, E, wave);
            SEAM(pb + 7);
        }
#endif
#if PH_ON(8)
        if (li == 1 && IN(pb + 8)) { const int wave = opq_s(wave0), bid = opq_s((int)blockIdx.x), nwg = opq_s((int)gridDim.x); (void)bid; (void)nwg;
            const int ln = li + 1;
            const int nb = LB(ln), fo = FO(ln);
            const ConvP C{args.in[nb], args.in[nb + 1], args.in[nb + OO(ln)], args.in[nb + fo], args.in[nb + fo + 1], args.in[nb + fo + 3],
                          ln == 2 ? args.in[35] : nullptr, ln == 2 ? args.in[37] : nullptr, ln == 2 ? args.in[38] : nullptr, ln == 2 ? args.in[46] : nullptr, ln == 2 ? args.in[36] : nullptr, ln == 2 ? args.in[45] : nullptr};
            const int lane = lane_id_opaque(), tid = wave * 64 + lane;
            convert_layer(C, ln, ws, lds, wave, lane, tid, bid, nwg, bid, 32 * (NPROJ / 128), nwg, true);
#if REP_CV > 1
            __syncthreads();
            convert_layer(C, ln, ws, lds, wave, lane_id_opaque(), wave * 64 + lane_id_opaque(), bid, nwg, bid, 32 * (NPROJ / 128), nwg, true);
#endif
            SEAM(pb + 8);
        }
#endif
    }
#ifdef SCAN_CHK
    {
        xcd_barrier(bar);
        float e = __uint_as_float(__hip_atomic_load(ctl + CW_DBG, RLX_AGENT));
        { const float l2_ = __uint_as_float(__hip_atomic_load(ctl + CW_DBG + 64, RLX_AGENT)); if (l2_ > 0.f) e = l2_; }
        float* o = args.out; const size_t n = (size_t)M * DM;
        for (size_t i = (size_t)blockIdx.x * NTHREADS + threadIdx.x; i < n; i += (size_t)gridDim.x * NTHREADS) o[i] *= (1.0f + 100.0f * e);
    }
#endif
#undef IN
#undef SEAM
}

#ifdef PROBE_OFF
__global__ void mk_probe(const unsigned short* src, int ld, int coloff, float* out) {
    const size_t n = (size_t)M * DM;
    for (size_t i = (size_t)blockIdx.x * blockDim.x + threadIdx.x; i < n; i += (size_t)gridDim.x * blockDim.x) {
        const size_t r = i / DM, c = (i % DM) % PROBE_NC; float v_ = __uint_as_float(((unsigned)src[r * ld + coloff + c]) << 16); out[i] = (v_ - v_ == 0.f) ? v_ : 1000.0f; }
}
#endif
#ifndef MK_N_LAUNCHES
#define MK_N_LAUNCHES 1
#endif
extern "C" void kernel_launch(void* const* d_in, const int* in_sizes, int n_in, void* d_out, int out_size, void* d_ws, size_t ws_size, hipStream_t stream) {
    static int grid = 0;
    if (grid == 0) {
        if (n_in != N_IN || in_sizes[0] != M * DM || out_size != M * DM || ws_size < WS_END) {
            fprintf(stderr, "kernel_launch: built for %d inputs, x/out of %d floats, >= %zu bytes of workspace; got n_in %d, in0 %d, out %d, ws %zu; nothing launched\n", N_IN, M * DM, (size_t)WS_END, n_in, n_in > 0 ? in_sizes[0] : -1, out_size, ws_size);
            grid = -1; return; }
        int dev = 0, cus = 0, per_cu = 0;
        if (hipGetDevice(&dev) != hipSuccess || hipDeviceGetAttribute(&cus, hipDeviceAttributeMultiprocessorCount, dev) != hipSuccess) { grid = -1; return; }
        if (hipFuncSetAttribute((const void*)mk_fwd, hipFuncAttributeMaxDynamicSharedMemorySize, LDS_BYTES) != hipSuccess) { fprintf(stderr, "kernel_launch: hipFuncSetAttribute failed\n"); grid = -1; return; }
        if (hipOccupancyMaxActiveBlocksPerMultiprocessor(&per_cu, (const void*)mk_fwd, NTHREADS, LDS_BYTES) != hipSuccess || per_cu < 1)
            fprintf(stderr, "kernel_launch: note: occupancy query reports %d workgroups per CU\n", per_cu);
        (void)hipGetLastError();
        grid = cus;
    }
    if (grid < 0) return;
    if (hipMemsetAsync((char*)d_ws + WS_CTL, 0, CTL_ZERO_BYTES, stream) != hipSuccess) { fprintf(stderr, "kernel_launch: hipMemsetAsync failed\n"); return; }
    Args a{};
    for (int i = 0; i < N_IN; ++i) a.in[i] = (const float*)d_in[i];
    a.out = (float*)d_out; a.ws = (unsigned char*)d_ws;
#if MK_N_LAUNCHES == 1
    a.ph_lo = 0; a.ph_hi = N_PHASES;
    hipLaunchKernelGGL(mk_fwd, dim3(grid), dim3(NTHREADS), LDS_BYTES, stream, a);
#else
#ifndef PROBE_LAST
#define PROBE_LAST (N_PHASES - 1)
#endif
    for (int p = 0; p <= PROBE_LAST; ++p) { a.ph_lo = p; a.ph_hi = p + 1; hipLaunchKernelGGL(mk_fwd, dim3(grid), dim3(NTHREADS), LDS_BYTES, stream, a); }
#ifdef PROBE_OFF
    hipLaunchKernelGGL(mk_probe, dim3(2048), dim3(256), 0, stream, (const unsigned short*)((const unsigned char*)d_ws + (size_t)(PROBE_OFF)), (int)(PROBE_LD), (int)(PROBE_COL), (float*)d_out);
#endif
#endif
    const hipError_t le = hipPeekAtLastError();
    if (le != hipSuccess) fprintf(stderr, "kernel_launch: launch failed: %s\n", hipGetErrorName(le));
}
```

```cpp
#include <hip/hip_runtime.h>
#include <cstdio>
#include <cstdint>
__device__ __forceinline__ int lane_id_opaque() { int l; asm volatile("v_mbcnt_lo_u32_b32 %0, -1, 0\n\tv_mbcnt_hi_u32_b32 %0, -1, %0" : "=v"(l)); return l; }
__device__ __forceinline__ int opq_s(int x) { asm volatile("" : "+s"(x)); return x; }
template <int CTRL> __device__ __forceinline__ float dppx(float x) { return __builtin_bit_cast(float, __builtin_amdgcn_mov_dpp(__builtin_bit_cast(int, x), CTRL, 0xf, 0xf, true)); }
__device__ __forceinline__ float xlane16(float x) { return __builtin_bit_cast(float, __builtin_amdgcn_ds_swizzle(__builtin_bit_cast(int, x), 0x401F)); }
__device__ __forceinline__ float sum_x32(float x) { auto rr = __builtin_amdgcn_permlane32_swap(__float_as_uint(x), __float_as_uint(x), false, false); return __uint_as_float(rr[0]) + __uint_as_float(rr[1]); }
__device__ __forceinline__ float xsum_rows4(float x) { x += xlane16(x); return sum_x32(x); }
__device__ __forceinline__ float asum16(float x) { x += dppx<0xB1>(x); x += dppx<0x4E>(x); x += dppx<0x141>(x); x += dppx<0x128>(x); return x; }
__device__ __forceinline__ float asum32(float x) { x = asum16(x); return x + xlane16(x); }
__device__ __forceinline__ float asum64(float x) { return sum_x32(asum32(x)); }
namespace pg8 {
#define PG8_LAS __attribute__((address_space(3)))
typedef unsigned short bf16_t;
typedef short bf16x8 __attribute__((ext_vector_type(8)));
typedef float f32x4 __attribute__((ext_vector_type(4)));
typedef unsigned u32x4 __attribute__((ext_vector_type(4)));
constexpr int BM = 256, BK = 64, HALF = 128, HTB = HALF * BK * 2  , STAGE_BYTES = 8 * HTB, NXCD = 8, WGM = 4;

__host__ __device__ __forceinline__ int lds_byte(int r, int c) { const int st = (r >> 4) * 2 + (c >> 5), rr = r & 15, cc = c & 31, ob = rr * 64 + cc * 2; return st * 1024 + (ob ^ (((ob >> 9) & 1) << 5)); }
__host__ __device__ __forceinline__ void stage_rc(int b, int& R, int& C) { const int st = b / 1024, sb = b % 1024, swz = sb ^ (((sb >> 9) & 1) << 5); R = (st >> 1) * 16 + swz / 64; C = (st & 1) * 32 + (swz % 64) / 2; }
__host__ __device__ __forceinline__ int perm32(int rho) { const int n = rho >> 4, i = rho & 15; return 8 * (i >> 2) + 4 * n + (i & 3); }

struct Unit { int pm, pn; };
struct Gemm { const bf16_t* A; const bf16_t* Bt; int M, N, K; };

struct StaticOrder {
    int nM, nN, nwg, G, c;
    __host__ __device__ void init(int M, int N, int G_, int c_) { nM = M / BM; nN = N / BM; nwg = nM * nN; G = G_; c = c_; }
    __host__ __device__ __forceinline__ bool next(int i, Unit& u) const {
        const long L = (long)i * G + c; if (L >= nwg) return false;
        int wgid = (int)L; { const int q = nwg / NXCD, r = nwg % NXCD, xcd = wgid % NXCD, off = wgid / NXCD; wgid = (xcd < r ? xcd * (q + 1) : r * (q + 1) + (xcd - r) * q) + off; }
        const int nig = WGM * nN, gid = wgid / nig, fm = gid * WGM, gsz = (nM - fm) < WGM ? (nM - fm) : WGM;
        u.pm = fm + ((wgid % nig) % gsz); u.pn = (wgid % nig) / gsz; return true;
    }
    __device__ __forceinline__ void a_ready(const Unit&) const {}
    __device__ __forceinline__ void done(const Unit&) const {}
};
struct HotOrder : StaticOrder {
    __host__ __device__ bool next(int i, Unit& u) const { const bool ok = StaticOrder::next(i, u); u.pm = 0; u.pn = 0; return ok; }
};

__device__ __forceinline__ unsigned cvt_pk_bf16(float lo, float hi) { unsigned r; asm volatile("v_cvt_pk_bf16_f32 %0, %1, %2" : "=v"(r) : "v"(lo), "v"(hi)); return r; }
__device__ __forceinline__ float bf_lo(unsigned u) { return __uint_as_float(u << 16); }
__device__ __forceinline__ float bf_hi(unsigned u) { return __uint_as_float(u & 0xffff0000u); }
typedef unsigned u32x2 __attribute__((ext_vector_type(2)));
__device__ __forceinline__ f32x4 ld_bf4(const bf16_t* p) { const u32x2 w = *(const u32x2*)p; return (f32x4){bf_lo(w.x), bf_hi(w.x), bf_lo(w.y), bf_hi(w.y)}; }
__device__ __forceinline__ void st_bf4(bf16_t* p, f32x4 v) { u32x2 w; w.x = cvt_pk_bf16(v[0], v[1]); w.y = cvt_pk_bf16(v[2], v[3]); *(u32x2*)p = w; }
__device__ __forceinline__ float sigmoidf_(float x) { return __builtin_amdgcn_rcpf(1.0f + __expf(-x)); }

struct EpiNull {
    static constexpr bool PERM = true, AFTER_DRAIN = false, ROWPERM = false;
    __device__ __forceinline__ void operator()(const f32x4 (&acc)[2][2][4][2], const Unit&, int, int, int, int) const {
#pragma unroll
        for (int a = 0; a < 2; ++a)
#pragma unroll
            for (int c = 0; c < 2; ++c)
#pragma unroll
                for (int m = 0; m < 4; ++m) { asm volatile("" :: "v"(acc[a][c][m][0])); asm volatile("" :: "v"(acc[a][c][m][1])); }
    }
};
struct RowScale {
    PG8_LAS float* t;
    __device__ __forceinline__ RowScale(const float* rs, PG8_LAS float* SCW, int pm, int wr, int wc, int fr, int fq) {
        const int lane = fq * 16 + fr; t = SCW + (wr * 4 + wc) * 128;
        const float* p = rs + (size_t)(pm * BM + wr * 64 + lane) * 8;
        const f32x4 a0 = *(const f32x4*)p, a1 = *(const f32x4*)(p + 4), b0 = *(const f32x4*)(p + HALF * 8), b1 = *(const f32x4*)(p + HALF * 8 + 4);
        t[lane] = rsqrtf((((a0[0] + a0[1]) + (a0[2] + a0[3])) + ((a1[0] + a1[1]) + (a1[2] + a1[3]))) * (1.0f / 2048.0f) + 1e-6f);
        t[64 + lane] = rsqrtf((((b0[0] + b0[1]) + (b0[2] + b0[3])) + ((b1[0] + b1[1]) + (b1[2] + b1[3]))) * (1.0f / 2048.0f) + 1e-6f);
    }
    __device__ __forceinline__ float operator()(int ai, int m, int fr) const { return t[ai * 64 + m * 16 + fr]; }
};
struct EpiScaleBf16 {
    static constexpr bool PERM = true, AFTER_DRAIN = false, ROWPERM = false;
    bf16_t* O; int ldc; const float* rs; PG8_LAS float* SCW;
    __device__ __forceinline__ void operator()(const f32x4 (&acc)[2][2][4][2], const Unit& u, int wr, int wc, int fr, int fq) const {
        asm volatile("" : "+v"(fr), "+v"(fq));
        const RowScale RSC(rs, SCW, u.pm, wr, wc, fr, fq);
        const int row0 = u.pm * BM + wr * 64 + fr, col0 = u.pn * BM + wc * 32 + 8 * fq;
#pragma unroll
        for (int ai = 0; ai < 2; ++ai)
#pragma unroll
            for (int m = 0; m < 4; ++m) {
                const int row = row0 + ai * HALF + m * 16;
                const float sc = RSC(ai, m, fr);
                bf16_t* rowp = O + (size_t)row * ldc + col0;
#pragma unroll
                for (int bj = 0; bj < 2; ++bj) { const f32x4 v0 = acc[ai][bj][m][0] * sc, v1 = acc[ai][bj][m][1] * sc;
                    u32x4 w; w.x = cvt_pk_bf16(v0[0], v0[1]); w.y = cvt_pk_bf16(v0[2], v0[3]); w.z = cvt_pk_bf16(v1[0], v1[1]); w.w = cvt_pk_bf16(v1[2], v1[3]);
                    *(u32x4*)(rowp + bj * HALF) = w; } }
    }
};
struct EpiProj {
    static constexpr bool PERM = true, AFTER_DRAIN = false, ROWPERM = false;
    bf16_t* O; int ncols; const float* rs; const float *q_gain, *k_gain; bf16_t *QN, *KN, *VV; float* KMEAN; PG8_LAS float* X; PG8_LAS float* SCW;
    __device__ __forceinline__ void operator()(const f32x4 (&acc)[2][2][4][2], const Unit& u, int wr, int wc, int fr, int fq) const {
        asm volatile("" : "+v"(fr), "+v"(fq));
        const RowScale RSC(rs, SCW, u.pm, wr, wc, fr, fq);
        const int pn = u.pn, d0 = wc * 32 + 8 * fq;
        if (pn >= 12) {
            const int row0 = u.pm * BM + wr * 64 + fr, col0 = pn * BM + d0;
#pragma unroll
            for (int ai = 0; ai < 2; ++ai)
#pragma unroll
                for (int m = 0; m < 4; ++m) { const int row = row0 + ai * HALF + m * 16; const float sc = RSC(ai, m, fr); bf16_t* rowp = O + (size_t)row * 6656 + col0;
#pragma unroll
                    for (int bj = 0; bj < 2; ++bj) { const f32x4 v0 = acc[ai][bj][m][0] * sc, v1 = acc[ai][bj][m][1] * sc;
                        u32x4 w; w.x = cvt_pk_bf16(v0[0], v0[1]); w.y = cvt_pk_bf16(v0[2], v0[3]); w.z = cvt_pk_bf16(v1[0], v1[1]); w.w = cvt_pk_bf16(v1[2], v1[3]);
                        if (col0 + bj * HALF < ncols) *(u32x4*)(rowp + bj * HALF) = w; } }
            return; }
        const int typ = pn >> 2, hb = 2 * (pn & 3), bb = u.pm >> 3, blk = u.pm & 7;
        if (typ == 2) {
#pragma unroll
            for (int ai = 0; ai < 2; ++ai)
#pragma unroll
                for (int m = 0; m < 4; ++m) { const int rl = ai * HALF + wr * 64 + m * 16 + fr; const float sc = RSC(ai, m, fr);
#pragma unroll
                    for (int bj = 0; bj < 2; ++bj) { const f32x4 v0 = acc[ai][bj][m][0] * sc, v1 = acc[ai][bj][m][1] * sc;
                        u32x4 w; w.x = cvt_pk_bf16(v0[0], v0[1]); w.y = cvt_pk_bf16(v0[2], v0[3]); w.z = cvt_pk_bf16(v1[0], v1[1]); w.w = cvt_pk_bf16(v1[2], v1[3]);
                        *(u32x4*)(VV + (((size_t)bb * 8 + hb + bj) * 2048 + blk * 256 + rl) * 128 + d0) = w; } }
            return; }
#pragma unroll
        for (int ai = 0; ai < 2; ++ai)
#pragma unroll
            for (int m = 0; m < 4; ++m) { const int rl = ai * HALF + wr * 64 + m * 16 + fr; const float sc = RSC(ai, m, fr);
#pragma unroll
                for (int bj = 0; bj < 2; ++bj) { const f32x4 v0 = acc[ai][bj][m][0] * sc, v1 = acc[ai][bj][m][1] * sc;
                    float ss = (v0[0] * v0[0] + v0[1] * v0[1]) + (v0[2] * v0[2] + v0[3] * v0[3]) + (v1[0] * v1[0] + v1[1] * v1[1]) + (v1[2] * v1[2] + v1[3] * v1[3]);
                    ss = xsum_rows4(ss);
                    if (fq == 0) X[(rl * 4 + wc) * 2 + bj] = ss; } }
        asm volatile("s_waitcnt lgkmcnt(0)" ::: "memory"); __builtin_amdgcn_s_barrier(); asm volatile("" ::: "memory");
        const float* gain = typ ? k_gain : q_gain; bf16_t* dst = typ ? KN : QN;
        const f32x4 g0 = *(const f32x4*)(gain + d0), g1 = *(const f32x4*)(gain + d0 + 4);
#pragma unroll
        for (int ai = 0; ai < 2; ++ai)
#pragma unroll
            for (int m = 0; m < 4; ++m) { const int rl = ai * HALF + wr * 64 + m * 16 + fr; const float sc = RSC(ai, m, fr);
                const f32x4 xa = *(const PG8_LAS f32x4*)(X + rl * 8), xb_ = *(const PG8_LAS f32x4*)(X + rl * 8 + 4);
#pragma unroll
                for (int bj = 0; bj < 2; ++bj) { const float tot = bj ? (xa[1] + xa[3]) + (xb_[1] + xb_[3]) : (xa[0] + xa[2]) + (xb_[0] + xb_[2]);
                    const float f = sc * rsqrtf(tot * (1.0f / 128.0f) + 1e-6f);
                    const f32x4 v0 = acc[ai][bj][m][0] * f * g0, v1 = acc[ai][bj][m][1] * f * g1;
                    u32x4 w; w.x = cvt_pk_bf16(v0[0], v0[1]); w.y = cvt_pk_bf16(v0[2], v0[3]); w.z = cvt_pk_bf16(v1[0], v1[1]); w.w = cvt_pk_bf16(v1[2], v1[3]);
                    *(u32x4*)(dst + (((size_t)bb * 8 + hb + bj) * 2048 + blk * 256 + rl) * 128 + d0) = w; } }
    }
};
struct EpiResid {
    static constexpr bool PERM = true, AFTER_DRAIN = false, ROWPERM = false;
    float* xout; bf16_t* xb; float* rs_out; PG8_LAS float* X;
    __device__ __forceinline__ void operator()(const f32x4 (&acc)[2][2][4][2], const Unit& u, int wr, int wc, int fr, int fq) const {
        asm volatile("" : "+v"(fr), "+v"(fq));
        const int row0 = u.pm * BM + wr * 64 + fr, col0 = u.pn * BM + wc * 32 + 8 * fq;
        bf16_t* base = xb + (size_t)row0 * 2048 + col0;
        u32x4 xo[2][4][2];
#pragma unroll
        for (int ai = 0; ai < 2; ++ai)
#pragma unroll
            for (int m = 0; m < 4; ++m) { const bf16_t* p = base + (size_t)(ai * HALF + m * 16) * 2048; xo[ai][m][0] = *(const u32x4*)p; xo[ai][m][1] = *(const u32x4*)(p + HALF); }
#pragma unroll
        for (int ai = 0; ai < 2; ++ai)
#pragma unroll
            for (int m = 0; m < 4; ++m) {
                const size_t off = (size_t)(row0 + ai * HALF + m * 16) * 2048 + col0; float ss = 0.f;
#pragma unroll
                for (int bj = 0; bj < 2; ++bj) { const u32x4 xw = xo[ai][m][bj];
                    const f32x4 v0 = acc[ai][bj][m][0] + (f32x4){bf_lo(xw.x), bf_hi(xw.x), bf_lo(xw.y), bf_hi(xw.y)}, v1 = acc[ai][bj][m][1] + (f32x4){bf_lo(xw.z), bf_hi(xw.z), bf_lo(xw.w), bf_hi(xw.w)};
                    if (xout) { *(f32x4*)(xout + off + bj * HALF) = v0; *(f32x4*)(xout + off + bj * HALF + 4) = v1; continue; }
                    u32x4 w; w.x = cvt_pk_bf16(v0[0], v0[1]); w.y = cvt_pk_bf16(v0[2], v0[3]); w.z = cvt_pk_bf16(v1[0], v1[1]); w.w = cvt_pk_bf16(v1[2], v1[3]);
                    *(u32x4*)(xb + off + bj * HALF) = w;
                    ss += (v0[0] * v0[0] + v0[1] * v0[1]) + (v0[2] * v0[2] + v0[3] * v0[3]) + (v1[0] * v1[0] + v1[1] * v1[1]) + (v1[2] * v1[2] + v1[3] * v1[3]); }
                if (xout) continue;
                ss = xsum_rows4(ss);
                if (fq == 0) X[(ai * HALF + wr * 64 + m * 16 + fr) * 4 + wc] = ss; }
        if (xout) return;
        asm volatile("s_waitcnt lgkmcnt(0)" ::: "memory"); __builtin_amdgcn_s_barrier(); asm volatile("" ::: "memory");
        if (wc == 0) {
            const int lane = fq * 16 + fr;
#pragma unroll
            for (int ai = 0; ai < 2; ++ai) { const int rl = ai * HALF + wr * 64 + lane; const f32x4 xs = *(const PG8_LAS f32x4*)(X + rl * 4);
                rs_out[(size_t)(u.pm * BM + rl) * 8 + u.pn] = (xs[0] + xs[1]) + (xs[2] + xs[3]); } }
    }
};
template <int NQ> struct TapTable {
    PG8_LAS float* t;
    __device__ __forceinline__ TapTable(PG8_LAS float* base, int wr, int wc) { t = base + (wr * 4 + wc) * 256; }
    __device__ __forceinline__ void put(int idx, f32x4 v) const { *(PG8_LAS f32x4*)(t + idx * 4) = v; }
    __device__ __forceinline__ f32x4 get(int n, int q, int fq) const { return *(const PG8_LAS f32x4*)(t + ((n * NQ + q) * 4 + fq) * 4); }
};
template <int CTRL> __device__ __forceinline__ float dpp_upd(float old, float src) { return __builtin_bit_cast(float, __builtin_amdgcn_update_dpp(__builtin_bit_cast(int, old), __builtin_bit_cast(int, src), CTRL, 0xf, 0xf, false)); }
template <int CTRL> __device__ __forceinline__ float dpp_mov(float src) { return __builtin_bit_cast(float, __builtin_amdgcn_mov_dpp(__builtin_bit_cast(int, src), CTRL, 0xf, 0xf, true)); }
__device__ __forceinline__ float row_prev1(float cur, float prevm) { return dpp_upd<0x111>(dpp_mov<0x121>(prevm), cur); }
__device__ __forceinline__ float row_prev2(float cur, float prevm) { return dpp_upd<0x112>(dpp_mov<0x122>(prevm), cur); }
struct EpiUpConv {
    static constexpr bool PERM = true, AFTER_DRAIN = false, ROWPERM = true;
    typedef float f32x2 __attribute__((ext_vector_type(2)));
    bf16_t* ACT; bf16_t* HALO; const float* rs; PG8_LAS float* SCW; const float* cw; PG8_LAS float* TAPS;
    __device__ __forceinline__ static f32x2 shr1(f32x2 v) { return (f32x2){dpp_mov<0x111>(v.x), dpp_mov<0x111>(v.y)}; }
    __device__ __forceinline__ void operator()(const f32x4 (&acc)[2][2][4][2], const Unit& u, int wr, int wc, int fr, int fq) const {
        asm volatile("" : "+v"(fr), "+v"(fq));
        const int c0 = wc * 32 + 8 * fq;
        PG8_LAS float* tt = TAPS + (wr * 4 + wc) * 256;
        { int idx = fq * 16 + fr; if (idx >= 48) idx -= 16; const int n_ = idx / 24, q_ = (idx >> 2) % 6, f_ = idx & 3;
          const f32x4 t4 = *(const f32x4*)(cw + (q_ % 3) * 11264 + (q_ >= 3 ? 5632 : 0) + u.pn * 128 + wc * 32 + 8 * f_ + 4 * n_) * (q_ >= 3 ? -0.6931471806f : -1.4426950409f);
          PG8_LAS float* d_ = tt + (f_ * 2 + n_) * 24 + (q_ % 3) * 2 + (q_ >= 3 ? 1 : 0);
          d_[0] = t4[0]; d_[6] = t4[1]; d_[12] = t4[2]; d_[18] = t4[3]; }
        const RowScale RSC(rs, SCW, u.pm, wr, wc, fr, fq);
#pragma unroll
        for (int ai = 0; ai < 2; ++ai) {
            const int sg = u.pm * 4 + ai * 2 + wr;
            const f32x4 sc = *(const PG8_LAS f32x4*)(RSC.t + ai * 64 + 4 * fr);
            unsigned pk0[4][2];
#pragma unroll
            for (int n = 0; n < 2; ++n) {
                const int chg = u.pn * 128 + c0 + 4 * n;
                f32x2 T[4][3];
                { const PG8_LAS f32x4* tp = (const PG8_LAS f32x4*)(tt + (fq * 2 + n) * 24);
#pragma unroll
                  for (int q = 0; q < 6; ++q) { const f32x4 w4 = tp[q]; T[(2 * q) / 3][(2 * q) % 3] = (f32x2){w4[0], w4[1]}; T[(2 * q + 1) / 3][(2 * q + 1) % 3] = (f32x2){w4[2], w4[3]}; } }
                f32x2 P[4][4];
#pragma unroll
                for (int m = 0; m < 4; ++m)
#pragma unroll
                    for (int e = 0; e < 4; ++e) P[m][e] = (f32x2){acc[ai][0][m][n][e] * sc[m], acc[ai][1][m][n][e] * sc[m]};
                f32x2 Pm1[4], Pm2[4];
#pragma unroll
                for (int e = 0; e < 4; ++e) { Pm1[e] = shr1(P[3][e]); Pm2[e] = shr1(P[2][e]); }
#pragma unroll
                for (int m = 0; m < 4; ++m) {
                    float o[4];
#pragma unroll
                    for (int e = 0; e < 4; ++e) { const f32x2 a = m >= 2 ? P[m - 2][e] : (m == 1 ? Pm1[e] : Pm2[e]), bq = m >= 1 ? P[m - 1][e] : Pm1[e];
                        const f32x2 C = T[e][0] * a + T[e][1] * bq + T[e][2] * P[m][e];
                        o[e] = (C.x * C.y) * __builtin_amdgcn_rcpf(1.0f + __builtin_amdgcn_exp2f(C.x)); }
                    const int row = u.pm * BM + ai * HALF + wr * 64 + 4 * fr + m;
                    const bool head = (m < 2) && (fr == 0);
                    if (n == 0) { pk0[m][0] = cvt_pk_bf16(o[0], o[1]); pk0[m][1] = cvt_pk_bf16(o[2], o[3]); }
                    else if (!head) { u32x4 w; w.x = pk0[m][0]; w.y = pk0[m][1]; w.z = cvt_pk_bf16(o[0], o[1]); w.w = cvt_pk_bf16(o[2], o[3]); *(u32x4*)(ACT + (size_t)row * 5632 + chg - 4) = w; }
                }
                if (fr == 0 || fr == 15) {
                    const int ma = fr == 0 ? 0 : 2;
                    bf16_t* hp = HALO + ((size_t)sg * 4 + ma) * 11264 + u.pn * BM + c0 + 4 * n;
#pragma unroll
                    for (int k = 0; k < 2; ++k) { f32x2 q0 = fr == 0 ? P[k][0] : P[2 + k][0], q1 = fr == 0 ? P[k][1] : P[2 + k][1], q2 = fr == 0 ? P[k][2] : P[2 + k][2], q3 = fr == 0 ? P[k][3] : P[2 + k][3];
                        st_bf4(hp + k * 11264, (f32x4){q0.x, q1.x, q2.x, q3.x}); st_bf4(hp + k * 11264 + HALF, (f32x4){q0.y, q1.y, q2.y, q3.y}); } }
            }
            asm volatile("" ::: "memory");
        }
    }
};
constexpr int CV_PITCH = 2112;
struct EpiCU {
    static constexpr bool PERM = true, AFTER_DRAIN = false, ROWPERM = true;
    bf16_t* CV; bf16_t* HALO; const float* rs; PG8_LAS float* SCW; const float* cw; PG8_LAS float* TAPS;
    __device__ __forceinline__ void operator()(const f32x4 (&acc)[2][2][4][2], const Unit& u, int wr, int wc, int fr, int fq) const {
        asm volatile("" : "+v"(fr), "+v"(fq));
        const int c0 = wc * 32 + 8 * fq;
        const TapTable<3> TT(TAPS, wr, wc);
        { int idx = fq * 16 + fr; if (idx >= 48) idx -= 24; if (idx >= 24) idx -= 24; const int n_ = idx / 12, q_ = (idx >> 2) % 3, f_ = idx & 3;
          TT.put(idx, *(const f32x4*)(cw + q_ * 2048 + u.pn * 128 + wc * 32 + 8 * f_ + 4 * n_)); }
        const RowScale RSC(rs, SCW, u.pm, wr, wc, fr, fq);
#pragma unroll
        for (int ai = 0; ai < 2; ++ai) {
            const int sg = u.pm * 4 + ai * 2 + wr;
            const f32x4 sc = *(const PG8_LAS f32x4*)(RSC.t + ai * 64 + 4 * fr);
            unsigned pk0[4][2];
#pragma unroll
            for (int n = 0; n < 2; ++n) {
                const int ch = u.pn * 128 + c0 + 4 * n;
                const f32x4 g0 = TT.get(n, 0, fq), g1 = TT.get(n, 1, fq), g2 = TT.get(n, 2, fq);
                f32x4 cu[4];
#pragma unroll
                for (int m = 0; m < 4; ++m) cu[m] = (acc[ai][0][m][n] * sc[m]) * (acc[ai][1][m][n] * sc[m]);
                f32x4 cm1, cm2;
#pragma unroll
                for (int e = 0; e < 4; ++e) { cm1[e] = dpp_mov<0x111>(cu[3][e]); cm2[e] = dpp_mov<0x111>(cu[2][e]); }
#pragma unroll
                for (int m = 0; m < 4; ++m) {
                    const f32x4 ca = m >= 2 ? cu[m - 2] : (m == 1 ? cm1 : cm2), cb = m >= 1 ? cu[m - 1] : cm1;
                    const f32x4 o = g0 * ca + g1 * cb + g2 * cu[m];
                    const int row = u.pm * BM + ai * HALF + wr * 64 + 4 * fr + m;
                    const bool head = (m < 2) && (fr == 0);
                    if (n == 0) { pk0[m][0] = cvt_pk_bf16(o[0], o[1]); pk0[m][1] = cvt_pk_bf16(o[2], o[3]); }
                    else if (!head) { u32x4 w; w.x = pk0[m][0]; w.y = pk0[m][1]; w.z = cvt_pk_bf16(o[0], o[1]); w.w = cvt_pk_bf16(o[2], o[3]); *(u32x4*)(CV + (size_t)row * CV_PITCH + ch - 4) = w; }
                }
                if (fr == 0 || fr == 15) { const bool hd = fr == 0; const f32x4 ca_ = hd ? cu[0] : cu[2], cb_ = hd ? cu[1] : cu[3];
                    bf16_t* hp = HALO + ((size_t)sg * 4 + (hd ? 0 : 2)) * 2048 + ch; st_bf4(hp, ca_); st_bf4(hp + 2048, cb_); }
            }
            asm volatile("" ::: "memory");
        }
    }
};
struct EpiGateB {
    static constexpr bool PERM = true, AFTER_DRAIN = false, ROWPERM = false;
    bf16_t* O; const bf16_t* CV; const float* rs; PG8_LAS float* SCW;
    __device__ __forceinline__ void operator()(const f32x4 (&acc)[2][2][4][2], const Unit& u, int wr, int wc, int fr, int fq) const {
        asm volatile("" : "+v"(fr), "+v"(fq));
        const RowScale RSC(rs, SCW, u.pm, wr, wc, fr, fq);
        const int row0 = u.pm * BM + wr * 64 + fr, col0 = u.pn * BM + wc * 32 + 8 * fq;
#pragma unroll
        for (int ai = 0; ai < 2; ++ai)
#pragma unroll
            for (int m = 0; m < 4; ++m) {
                const int row = row0 + ai * HALF + m * 16;
                const float sc = RSC(ai, m, fr);
#pragma unroll
                for (int bj = 0; bj < 2; ++bj) { const size_t o = (size_t)row * 2048 + col0 + bj * HALF;
                    const u32x4 cw_ = *(const u32x4*)(CV + (size_t)row * CV_PITCH + col0 + bj * HALF);
                    const f32x4 v0 = acc[ai][bj][m][0] * sc, v1 = acc[ai][bj][m][1] * sc;
                    u32x4 w; w.x = cvt_pk_bf16(v0[0] * bf_lo(cw_.x), v0[1] * bf_hi(cw_.x)); w.y = cvt_pk_bf16(v0[2] * bf_lo(cw_.y), v0[3] * bf_hi(cw_.y));
                    w.z = cvt_pk_bf16(v1[0] * bf_lo(cw_.z), v1[1] * bf_hi(cw_.z)); w.w = cvt_pk_bf16(v1[2] * bf_lo(cw_.w), v1[3] * bf_hi(cw_.w));
                    *(u32x4*)(O + o) = w; } }
    }
};
struct LaneXp {
    int idxT, idxF, rT, cT;
    __device__ __forceinline__ LaneXp(int fr, int fq) { rT = fq * 4 + (fr >> 2); cT = fr & 3; idxT = (cT * 16 + rT) << 2; idxF = (fr * 4 + fq) << 2; }
    __device__ __forceinline__ static unsigned g1(unsigned v, int idx) { return (unsigned)__builtin_amdgcn_ds_bpermute(idx, (int)v); }
    __device__ __forceinline__ u32x4 to(u32x4 v) const { u32x4 r; r.x = g1(v.x, idxT); r.y = g1(v.y, idxT); r.z = g1(v.z, idxT); r.w = g1(v.w, idxT); return r; }
    __device__ __forceinline__ u32x2 to(u32x2 v) const { u32x2 r; r.x = g1(v.x, idxT); r.y = g1(v.y, idxT); return r; }
    __device__ __forceinline__ u32x2 from(u32x2 v) const { u32x2 r; r.x = g1(v.x, idxF); r.y = g1(v.y, idxF); return r; }
};
struct EpiLora {
    static constexpr bool PERM = false, AFTER_DRAIN = false, ROWPERM = false;
    const bf16_t* proj;
    const float *shift_mu, *w0, *a0, *v0, *k_k, *k_a, *r_k;
    bf16_t* vfirst;
    unsigned *P0, *P1, *P2, *P3; float* PC; float* BON;
    PG8_LAS float* X;
    struct Raw { u32x2 rc, rp, kc, kp, vc, vp, vf; };
    __device__ __forceinline__ static f32x4 up4(u32x2 w) { return (f32x4){bf_lo(w.x), bf_hi(w.x), bf_lo(w.y), bf_hi(w.y)}; }
    __device__ __forceinline__ void operator()(const f32x4 (&acc)[2][2][4][2], const Unit& u, int wr, int wc, int fr, int fq) const {
        asm volatile("" : "+v"(fr), "+v"(fq));
        const LaneXp xp(fr, fq);
        const int h = u.pn, ch = 64 * h + 16 * wc + 4 * fq, chT = 64 * h + 16 * wc + 4 * xp.cT;
        const f32x4 mu_k = *(const f32x4*)(shift_mu + 1024 + ch), kkc = *(const f32x4*)(k_k + ch);
        u32x2 kc8[8], kp8[8];
#pragma unroll
        for (int g = 0; g < 8; ++g) { const int rl = (g >> 2) * HALF + wr * 64 + (g & 3) * 16 + xp.rT, tok = u.pm * BM + rl; const int tp = (tok & 2047) ? tok - 1 : tok;
            kc8[g] = *(const u32x2*)(proj + (size_t)tok * 6656 + 4096 + chT); if ((g & 3) == 0) kp8[g] = *(const u32x2*)(proj + (size_t)tp * 6656 + 4096 + chT); }
#define E3_PREV(cur_, pm_) (u32x2){(unsigned)__builtin_amdgcn_update_dpp(__builtin_amdgcn_mov_dpp((int)(pm_).x, 0x121, 0xf, 0xf, true), (int)(cur_).x, 0x111, 0xf, 0xf, false), \
                                   (unsigned)__builtin_amdgcn_update_dpp(__builtin_amdgcn_mov_dpp((int)(pm_).y, 0x121, 0xf, 0xf, true), (int)(cur_).y, 0x111, 0xf, 0xf, false)}
#pragma unroll
        for (int g = 0; g < 8; ++g) { kc8[g] = xp.from(kc8[g]); if ((g & 3) == 0) kp8[g] = xp.from(kp8[g]); else kp8[g] = E3_PREV(kc8[g], kc8[g - 1]); }
#pragma unroll
        for (int g = 0; g < 8; ++g) { const int rl = (g >> 2) * HALF + wr * 64 + (g & 3) * 16 + fr, tok = u.pm * BM + rl;
            const f32x4 kc = up4(kc8[g]); f32x4 kp = up4(kp8[g]); if ((tok & 2047) == 0) kp = (f32x4){0.f, 0.f, 0.f, 0.f};
            const f32x4 ks = kc + mu_k * (kp - kc), kk = ks * kkc;
            float ss = (kk[0] * kk[0] + kk[1] * kk[1]) + (kk[2] * kk[2] + kk[3] * kk[3]);
            ss = xsum_rows4(ss);
            if (fq == 0) X[rl * 4 + wc] = ss; }
        asm volatile("s_waitcnt lgkmcnt(0)" ::: "memory"); __builtin_amdgcn_s_barrier(); asm volatile("" ::: "memory");
        const f32x4 kac = *(const f32x4*)(k_a + ch), w0c = *(const f32x4*)(w0 + ch), mu_r = *(const f32x4*)(shift_mu + ch), mu_v = *(const f32x4*)(shift_mu + 2048 + ch), rkc = *(const f32x4*)(r_k + ch);
        Raw ra; u32x2 prc_ = (u32x2){0u, 0u}, pkc_ = prc_, pvc_ = prc_;
#define E3_LOAD(dst, g) do { const int rl_ = ((g) >> 2) * HALF + wr * 64 + ((g) & 3) * 16 + xp.rT, tok_ = u.pm * BM + rl_; const int tp_ = (tok_ & 2047) ? tok_ - 1 : tok_; \
            const bf16_t* pc_ = proj + (size_t)tok_ * 6656 + chT; const bf16_t* pp_ = proj + (size_t)tp_ * 6656 + chT; \
            dst.rc = *(const u32x2*)(pc_ + 3072); dst.kc = *(const u32x2*)(pc_ + 4096); dst.vc = *(const u32x2*)(pc_ + 5120); \
            if (((g) & 3) == 0) { dst.rp = *(const u32x2*)(pp_ + 3072); dst.kp = *(const u32x2*)(pp_ + 4096); dst.vp = *(const u32x2*)(pp_ + 5120); } \
            dst.vf = v0 ? *(const u32x2*)(vfirst + (size_t)tok_ * 1024 + chT) : (u32x2){0u, 0u}; } while (0)
#define E3_XP(dst, g) do { dst.rc = xp.from(dst.rc); dst.kc = xp.from(dst.kc); dst.vc = xp.from(dst.vc); if (v0) dst.vf = xp.from(dst.vf); \
            if (((g) & 3) == 0) { dst.rp = xp.from(dst.rp); dst.kp = xp.from(dst.kp); dst.vp = xp.from(dst.vp); } \
            else { dst.rp = E3_PREV(dst.rc, prc_); dst.kp = E3_PREV(dst.kc, pkc_); dst.vp = E3_PREV(dst.vc, pvc_); } \
            prc_ = dst.rc; pkc_ = dst.kc; pvc_ = dst.vc; } while (0)
#define E3_SCAN1(x, c) x += __builtin_bit_cast(float, __builtin_amdgcn_update_dpp(0, __builtin_bit_cast(int, x), c, 0xf, 0xf, true))
#define E3_BODY(g, cur) do { \
            const int ai = g >> 2, m = g & 3; \
            const int rl = ai * HALF + wr * 64 + m * 16 + fr, tok = u.pm * BM + rl; const bool first = (tok & 2047) == 0; const size_t o = (size_t)tok * 1024 + ch, oT = (size_t)(u.pm * BM + ai * HALF + wr * 64 + m * 16 + xp.rT) * 1024 + chT; (void)o; \
            const u32x2 zz_ = (u32x2){0u, 0u}; const u32x2 rpw = first ? zz_ : cur.rp, kpw = first ? zz_ : cur.kp, vpw = first ? zz_ : cur.vp; \
            const f32x4 xs = *(const PG8_LAS f32x4*)(X + rl * 4); \
            const float inv = __builtin_amdgcn_rsqf(fmaxf((xs[0] + xs[1]) + (xs[2] + xs[3]), 1e-24f));         \
            const f32x4 apre = acc[ai][0][m][1], wpre = acc[ai][0][m][0] + w0c, gg = acc[ai][1][m][0]; \
            f32x4 vs; { const f32x4 vc = up4(cur.vc), vp = up4(vpw); vs = vc + mu_v * (vp - vc); } \
            f32x4 vo; u32x4 w0_, w1_, w3_; \
            if (v0) { const f32x4 vf = up4(cur.vf), vpre = acc[ai][1][m][1]; \
                _Pragma("unroll") for (int j = 0; j < 4; ++j) vo[j] = vs[j] + (vf[j] - vs[j]) * sigmoidf_(vpre[j]); } \
            else { vo = vs; u32x2 pv_; pv_.x = cvt_pk_bf16(vs[0], vs[1]); pv_.y = cvt_pk_bf16(vs[2], vs[3]); *(u32x2*)(vfirst + oT) = xp.to(pv_); } \
            float Lj[4]; \
            _Pragma("unroll") for (int j = 0; j < 4; ++j) Lj[j] = -0.60653066f * sigmoidf_(wpre[j]);       \
            _Pragma("unroll") for (int j = 0; j < 4; ++j) E3_SCAN1(Lj[j], 0x111); \
            _Pragma("unroll") for (int j = 0; j < 4; ++j) E3_SCAN1(Lj[j], 0x112); \
            _Pragma("unroll") for (int j = 0; j < 4; ++j) E3_SCAN1(Lj[j], 0x114); \
            _Pragma("unroll") for (int j = 0; j < 4; ++j) E3_SCAN1(Lj[j], 0x118); \
            _Pragma("unroll") for (int j = 0; j < 4; ++j) { \
                const unsigned rcw_ = cur.rc[j >> 1], rpw_ = rpw[j >> 1], kcw_ = cur.kc[j >> 1], kpw_ = kpw[j >> 1]; \
                const float rc_ = (j & 1) ? bf_hi(rcw_) : bf_lo(rcw_), rp_ = (j & 1) ? bf_hi(rpw_) : bf_lo(rpw_), kc_ = (j & 1) ? bf_hi(kcw_) : bf_lo(kcw_), kp_ = (j & 1) ? bf_hi(kpw_) : bf_lo(kpw_); \
                const float rsj = rc_ + mu_r[j] * (rp_ - rc_), ksj = kc_ + mu_k[j] * (kp_ - kc_); \
                const float a = sigmoidf_(apre[j]), kkn = ksj * kkc[j] * inv; \
                const float ko_ = ksj * (1.0f + (a - 1.0f) * kac[j]), as_ = -kkn, bs_ = kkn * a; \
                const float e2 = __expf(Lj[j]), e3 = __builtin_amdgcn_rcpf(e2);                                \
                const float e1 = __builtin_bit_cast(float, __builtin_amdgcn_update_dpp(0x3f800000, __builtin_bit_cast(int, e2), 0x111, 0xf, 0xf, false));     \
                w0_[j] = cvt_pk_bf16(as_ * e1, rsj * e2); w1_[j] = cvt_pk_bf16(bs_ * e3, ko_ * e3); w3_[j] = cvt_pk_bf16(vo[j], gg[j]);     \
                vo[j] = e2; } \
            *(u32x4*)(P0 + oT) = xp.to(w0_); *(u32x4*)(P1 + oT) = xp.to(w1_); *(u32x4*)(P3 + oT) = xp.to(w3_); \
            if (fr == 15) *(f32x4*)(PC + (size_t)(tok >> 4) * 1024 + ch) = vo; \
        } while (0)
#pragma unroll
        for (int g2 = 0; g2 < 8; ++g2) {
            E3_LOAD(ra, g2);
            E3_XP(ra, g2);
            E3_BODY(g2, ra);
            asm volatile("" ::: "memory");
        }
#undef E3_BODY
#undef E3_SCAN1
#undef E3_LOAD
#undef E3_XP
#undef E3_PREV
    }
};

template <class Epi, class Sched, bool ALIGN_EPI = false, bool SP2 = false>
__device__ __forceinline__ void gemm_phase(PG8_LAS unsigned char* lds, const Gemm g, const Sched& S, const Epi& E, const int wave_in) {
    const int wid = wave_in, lane = lane_id_opaque(), tid = wid * 64 + lane, wr = wid >> 2, wc = wid & 3, fr = lane & 15, fq = lane >> 4;
    int K_o = g.K; asm volatile("" : "+s"(K_o));
    const int K = K_o, nt = K / BK;
    unsigned voffA[2], voffB[2];
#pragma unroll
    for (int i = 0; i < 2; ++i) { int R, C; stage_rc(tid * 16 + i * 8192, R, C); const int Rb = Epi::PERM ? ((R & ~31) + perm32(R & 31)) : R;
        const int Ra = Epi::ROWPERM ? ((R & ~63) + 4 * (R & 15) + ((R >> 4) & 3)) : R;
        voffA[i] = (unsigned)(Ra * K + C) * 2u; voffB[i] = (unsigned)(Rb * K + C) * 2u; }
    const size_t kstep = (size_t)(BK * 2);
    const size_t hstep = (size_t)HALF * K * 2;
    const size_t tstep = 2 * hstep;
    const unsigned ldsw = (unsigned)wid * 1024u;
    const int aoff = lds_byte(wr * 64 + fr, fq * 8), boff = lds_byte(wc * 32 + fr, fq * 8);
#define PG8_SA(b, h) (((b) * 2 + (h)) * HTB)
#define PG8_SB(b, h) ((4 + (b) * 2 + (h)) * HTB)
#define PG8_STAGE(bufoff, gbase, voff) do { _Pragma("unroll") for (int _i = 0; _i < 2; ++_i) \
        __builtin_amdgcn_global_load_lds((const unsigned*)((const char*)(gbase) + (voff)[_i]), (PG8_LAS unsigned*)(lds + (bufoff) + ldsw + _i * 8192), 16, 0, 0); } while (0)
#define PG8_LDA(dst, b, h) do { _Pragma("unroll") for (int m = 0; m < 4; ++m) _Pragma("unroll") for (int k = 0; k < 2; ++k) dst[m][k] = *(const PG8_LAS bf16x8*)(lds + PG8_SA(b, h) + aoff + m * 2048 + k * 1024); } while (0)
#define PG8_LDB(dst, b, h) do { _Pragma("unroll") for (int n = 0; n < 2; ++n) _Pragma("unroll") for (int k = 0; k < 2; ++k) dst[n][k] = *(const PG8_LAS bf16x8*)(lds + PG8_SB(b, h) + boff + n * 2048 + k * 1024); } while (0)
#ifdef KL_NOPRIO
#define PG8_PRIO(x)
#else
#define PG8_PRIO(x) __builtin_amdgcn_s_setprio(x)
#endif
#define PG8_MMA(ai, bj, At, Bt) do { PG8_PRIO(1); _Pragma("unroll") for (int m = 0; m < 4; ++m) _Pragma("unroll") for (int n = 0; n < 2; ++n) _Pragma("unroll") for (int k = 0; k < 2; ++k) \
        acc[ai][bj][m][n] = __builtin_amdgcn_mfma_f32_16x16x32_bf16(Bt[n][k], At[m][k], acc[ai][bj][m][n], 0, 0, 0); PG8_PRIO(0); } while (0)
#define PG8_WAIT_V(n) asm volatile("s_waitcnt vmcnt(" #n ")" ::: "memory")
#define PG8_WAIT_L(n) asm volatile("s_waitcnt lgkmcnt(" #n ")" ::: "memory")
#define PG8_BAR __builtin_amdgcn_s_barrier()
#ifdef KL_NOSCHED
#define PG8_SCHED
#else
#define PG8_SCHED __builtin_amdgcn_sched_barrier(0)
#endif
#define PG8_ZERO(ai) do { _Pragma("unroll") for (int b_ = 0; b_ < 2; ++b_) _Pragma("unroll") for (int m_ = 0; m_ < 4; ++m_) _Pragma("unroll") for (int n_ = 0; n_ < 2; ++n_) acc[ai][b_][m_][n_] = (f32x4){0.f, 0.f, 0.f, 0.f}; } while (0)
    Unit cur, nxt; int ui = 0;
    if (!S.next(0, cur)) return;
    f32x4 acc[2][2][4][2];
#pragma unroll
    for (int a = 0; a < 2; ++a)
#pragma unroll
        for (int b = 0; b < 2; ++b)
#pragma unroll
            for (int m = 0; m < 4; ++m)
#pragma unroll
                for (int n = 0; n < 2; ++n) acc[a][b][m][n] = (f32x4){0.f, 0.f, 0.f, 0.f};
    bf16x8 At[4][2], B0[2][2], B1[2][2];
    const char* cA = (const char*)g.A + (size_t)cur.pm * tstep; const char* cB = (const char*)g.Bt + (size_t)cur.pn * tstep;
    S.a_ready(cur);
    if constexpr (SP2) {
        PG8_STAGE(PG8_SB(0, 0), cB, voffB); PG8_STAGE(PG8_SB(0, 1), cB + hstep, voffB); PG8_STAGE(PG8_SA(0, 0), cA, voffA); PG8_STAGE(PG8_SA(0, 1), cA + hstep, voffA);
        if (wr == 1) PG8_BAR;
        PG8_WAIT_V(2); PG8_BAR;
        PG8_STAGE(PG8_SB(1, 0), cB + kstep, voffB); PG8_STAGE(PG8_SA(1, 0), cA + kstep, voffA); PG8_STAGE(PG8_SB(1, 1), cB + hstep + kstep, voffB);
        PG8_WAIT_V(6); PG8_BAR;
    } else {
        PG8_STAGE(PG8_SB(0, 0), cB, voffB); PG8_STAGE(PG8_SA(0, 0), cA, voffA); PG8_STAGE(PG8_SB(0, 1), cB + hstep, voffB); PG8_STAGE(PG8_SA(0, 1), cA + hstep, voffA);
        if (wr == 1) PG8_BAR;
        PG8_WAIT_V(4); PG8_BAR;
        PG8_STAGE(PG8_SB(1, 0), cB + kstep, voffB); PG8_STAGE(PG8_SA(1, 0), cA + kstep, voffA); PG8_STAGE(PG8_SB(1, 1), cB + hstep + kstep, voffB);
        PG8_WAIT_V(6); PG8_BAR;
    }
    for (;;) {
        const bool has_next = S.next(ui + 1, nxt);
        const char* nA = has_next ? (const char*)g.A + (size_t)nxt.pm * tstep : cA; const char* nB = has_next ? (const char*)g.Bt + (size_t)nxt.pn * tstep : cB;
        for (int t = 0; t < nt; t += 2) {
            const bool last = (t == nt - 2);
            const char* a1 = cA + (size_t)(t + 1) * kstep;
            const char* a2 = last ? nA : cA + (size_t)(t + 2) * kstep; const char* b2 = last ? nB : cB + (size_t)(t + 2) * kstep;
            const char* a3 = a2 + kstep; const char* b3 = b2 + kstep;
            if (last && has_next) S.a_ready(nxt);
            if constexpr (SP2) {
            PG8_LDB(B0, 0, 0); PG8_LDB(B1, 0, 1); PG8_SCHED; PG8_LDA(At, 0, 0); PG8_STAGE(PG8_SA(1, 1), a1 + hstep, voffA);
            if (t == 0 && ui > 0) { PG8_ZERO(0); PG8_SCHED; }
            PG8_WAIT_V(8); PG8_WAIT_L(0); PG8_BAR; PG8_MMA(0, 0, At, B0); PG8_MMA(0, 1, At, B1); PG8_BAR; PG8_SCHED;
            PG8_LDA(At, 0, 1); PG8_STAGE(PG8_SB(0, 0), b2, voffB); PG8_STAGE(PG8_SB(0, 1), b2 + hstep, voffB); PG8_STAGE(PG8_SA(0, 0), a2, voffA);
            if (t == 0 && ui > 0) { PG8_ZERO(1); PG8_SCHED; }
            PG8_WAIT_V(8); PG8_WAIT_L(0); PG8_BAR; PG8_MMA(1, 0, At, B0); PG8_MMA(1, 1, At, B1); PG8_BAR; PG8_SCHED;
            PG8_LDB(B0, 1, 0); PG8_LDB(B1, 1, 1); PG8_SCHED; PG8_LDA(At, 1, 0); PG8_STAGE(PG8_SA(0, 1), a2 + hstep, voffA);
            PG8_WAIT_V(8); PG8_WAIT_L(0); PG8_BAR; PG8_MMA(0, 0, At, B0); PG8_MMA(0, 1, At, B1); PG8_BAR; PG8_SCHED;
            PG8_LDA(At, 1, 1); PG8_STAGE(PG8_SB(1, 0), b3, voffB); PG8_STAGE(PG8_SB(1, 1), b3 + hstep, voffB); PG8_STAGE(PG8_SA(1, 0), a3, voffA);
            PG8_WAIT_V(8); PG8_WAIT_L(0); PG8_BAR; PG8_MMA(1, 0, At, B0); PG8_MMA(1, 1, At, B1); PG8_BAR; PG8_SCHED;
            } else {
            PG8_LDB(B0, 0, 0); PG8_SCHED; PG8_LDA(At, 0, 0); PG8_STAGE(PG8_SA(1, 1), a1 + hstep, voffA);
            PG8_WAIT_L(8); PG8_BAR; PG8_WAIT_L(0); PG8_MMA(0, 0, At, B0); PG8_BAR; PG8_SCHED;
            PG8_LDB(B1, 0, 1); PG8_STAGE(PG8_SB(0, 0), b2, voffB);
            PG8_BAR; PG8_WAIT_L(0); PG8_MMA(0, 1, At, B1); PG8_BAR;
            PG8_LDA(At, 0, 1); PG8_STAGE(PG8_SA(0, 0), a2, voffA);
            PG8_BAR; PG8_WAIT_L(0); PG8_MMA(1, 0, At, B0); PG8_BAR; PG8_SCHED;
            PG8_STAGE(PG8_SB(0, 1), b2 + hstep, voffB);
            PG8_WAIT_V(6); PG8_BAR; PG8_MMA(1, 1, At, B1); PG8_BAR;
            PG8_LDB(B0, 1, 0); PG8_SCHED; PG8_LDA(At, 1, 0); PG8_STAGE(PG8_SA(0, 1), a2 + hstep, voffA);
            PG8_WAIT_L(8); PG8_BAR; PG8_WAIT_L(0); PG8_MMA(0, 0, At, B0); PG8_BAR; PG8_SCHED;
            PG8_LDB(B1, 1, 1); PG8_STAGE(PG8_SB(1, 0), b3, voffB);
            PG8_BAR; PG8_WAIT_L(0); PG8_MMA(0, 1, At, B1); PG8_BAR;
            PG8_LDA(At, 1, 1); PG8_STAGE(PG8_SA(1, 0), a3, voffA);
            PG8_BAR; PG8_WAIT_L(0); PG8_MMA(1, 0, At, B0); PG8_BAR; PG8_SCHED;
            PG8_STAGE(PG8_SB(1, 1), b3 + hstep, voffB);
            PG8_WAIT_V(6); PG8_BAR; PG8_MMA(1, 1, At, B1); PG8_BAR;
            }
        }
        if constexpr (ALIGN_EPI) { if (wr == 0) PG8_BAR; }
        if constexpr (!Epi::AFTER_DRAIN) { E(acc, cur, wr, wc, fr, fq); S.done(cur); }
        if (!has_next) break;
        if constexpr (SP2) {
#pragma unroll
        for (int a = 0; a < 2; ++a)
#pragma unroll
            for (int b = 0; b < 2; ++b)
#pragma unroll
                for (int m = 0; m < 4; ++m)
#pragma unroll
                    for (int n = 0; n < 2; ++n) asm volatile("" : "=v"(acc[a][b][m][n]));
        }
        if constexpr (!SP2) {
#pragma unroll
        for (int a = 0; a < 2; ++a)
#pragma unroll
            for (int b = 0; b < 2; ++b)
#pragma unroll
                for (int m = 0; m < 4; ++m)
#pragma unroll
                    for (int n = 0; n < 2; ++n) acc[a][b][m][n] = (f32x4){0.f, 0.f, 0.f, 0.f};
        }
        cur = nxt; cA = nA; cB = nB; ++ui;
        if constexpr (ALIGN_EPI) { if (wr == 1) PG8_BAR; }
    }
    PG8_WAIT_V(0);
    if constexpr (!ALIGN_EPI) { if (wr == 0) PG8_BAR; }
    PG8_BAR;
    if constexpr (Epi::AFTER_DRAIN) { E.fused(acc, cur, wr, wc, fr, fq, lds, wid, lane); S.done(cur); }
#undef PG8_PRIO
#undef PG8_SA
#undef PG8_SB
#undef PG8_STAGE
#undef PG8_LDA
#undef PG8_LDB
#undef PG8_MMA
#undef PG8_ZERO
#undef PG8_WAIT_V
#undef PG8_WAIT_L
#undef PG8_BAR
#undef PG8_SCHED
}
}

namespace attn {
constexpr int D = 128, NW = 8, QBLK = 32, KVBLK = 64, QB = NW * QBLK;
constexpr int SHM_V = KVBLK * D * 2, SHM_K = KVBLK * D * 2;
constexpr int LDS_BYTES = 2 * SHM_V + 2 * SHM_K + NW * 64 * 4;
constexpr int KM_OFF = 69632;
constexpr float SCALE = 0.08838834764831845f, THR = 8.f;
typedef unsigned short bf16;
typedef short bf16x8 __attribute__((ext_vector_type(8)));
typedef short s16x4 __attribute__((ext_vector_type(4)));
typedef float f32x16 __attribute__((ext_vector_type(16)));
typedef float f32x4 __attribute__((ext_vector_type(4)));
typedef unsigned u32x4 __attribute__((ext_vector_type(4)));
#define KSWZ(row, colB) ((row) * 256 + ((colB) ^ (((row) & 7) << 4)))
#define SBAR() __builtin_amdgcn_sched_barrier(0)
__device__ __forceinline__ int v_st(int k, int c) { const int kk = (k & ~0xC) | ((k & 4) << 1) | ((k & 8) >> 1); return ((kk >> 3) * 4 + (c >> 5)) * 512 + ((kk & 7) * 32 + (c & 31)) * 2; }
__device__ __forceinline__ int v_rd_base(int lane) { return ((lane & 3) << 3) | (((lane >> 2) & 3) << 6) | (((lane >> 4) & 1) << 5) | (((lane >> 5) & 1) << 8); }
constexpr int v_rd_off(int d0, int ks, int half) { return d0 * 512 + ks * 4096 + half * 2048; }
__device__ __forceinline__ int crow(int r, int hi) { return (r & 3) + 8 * (r >> 2) + 4 * hi; }
__device__ __forceinline__ unsigned cvtpk(float lo, float hi) { unsigned r; asm volatile("v_cvt_pk_bf16_f32 %0, %1, %2" : "=v"(r) : "v"(lo), "v"(hi)); return r; }
__device__ __forceinline__ bf16x8 load8(const bf16* p) { return *reinterpret_cast<const bf16x8*>(p); }
__device__ __forceinline__ void moba_mask(f32x16& p0, f32x16& p1, int kb, int qm, int blk, unsigned selmask, float sr) {
    const float NEG = -__builtin_inff();
    const int n = kb >> 8, dq = qm - kb;
    const float base = -sr * (float)dq;
    if (n == blk) {
#pragma unroll
        for (int r = 0; r < 16; ++r) { const int c = (r & 3) + 8 * (r >> 2);
            p0[r] = (dq - c >= 0) ? fmaf(sr, (float)c, p0[r] + base) : NEG;
            p1[r] = (dq - c - 32 >= 0) ? fmaf(sr, (float)(c + 32), p1[r] + base) : NEG; }
    } else {
        const bool sel = ((selmask >> n) & 1u) != 0u;
#pragma unroll
        for (int r = 0; r < 16; ++r) { const int c = (r & 3) + 8 * (r >> 2);
            p0[r] = sel ? fmaf(sr, (float)c, p0[r] + base) : NEG;
            p1[r] = sel ? fmaf(sr, (float)(c + 32), p1[r] + base) : NEG; }
    }
}
__device__ __forceinline__ void partialSM(f32x16& p0, f32x16& p1, float& m_reg, float& mn, float& alpha) {
    float pmax = p0[0]; for (int r = 1; r < 16; ++r) pmax = fmaxf(pmax, p0[r]); for (int r = 0; r < 16; ++r) pmax = fmaxf(pmax, p1[r]);
    { auto rr = __builtin_amdgcn_permlane32_swap(__float_as_uint(pmax), __float_as_uint(pmax), false, false);
      pmax = fmaxf(__uint_as_float(rr[0]), __uint_as_float(rr[1])); }
    constexpr float C2 = 1.4426950408889634f * SCALE;
    if (__builtin_expect(__all((pmax - m_reg) * SCALE <= THR), 1)) { mn = m_reg; alpha = 1.f; }
    else { mn = fmaxf(m_reg, pmax); alpha = __builtin_amdgcn_exp2f((m_reg - mn) * C2); m_reg = mn; }
    const float mnL = -mn * C2;
    for (int r = 0; r < 16; ++r) p0[r] = fmaf(p0[r], C2, mnL); for (int r = 0; r < 16; ++r) p1[r] = fmaf(p1[r], C2, mnL);
    for (int r = 0; r < 16; ++r) p0[r] = __builtin_amdgcn_exp2f(p0[r]);
}
__device__ __forceinline__ void finishSM(f32x16& p0, f32x16& p1, float alpha, float& l_reg, bf16x8& pa0, bf16x8& pa1, bf16x8& pa2, bf16x8& pa3) {
    for (int r = 0; r < 16; ++r) p1[r] = __builtin_amdgcn_exp2f(p1[r]);
    float ps = 0; for (int r = 0; r < 16; ++r) ps += p0[r]; for (int r = 0; r < 16; ++r) ps += p1[r];
    { auto rr = __builtin_amdgcn_permlane32_swap(__float_as_uint(ps), __float_as_uint(ps), false, false);
      ps = __uint_as_float(rr[0]) + __uint_as_float(rr[1]); }
    l_reg = l_reg * alpha + ps;
#define PK4(P, B_, OUT) do { unsigned a0 = cvtpk(P[B_+0], P[B_+1]), a1 = cvtpk(P[B_+2], P[B_+3]);                          \
        unsigned b0 = cvtpk(P[B_+4], P[B_+5]), b1 = cvtpk(P[B_+6], P[B_+7]);                                             \
        auto r0 = __builtin_amdgcn_permlane32_swap(a0, b0, false, false); auto r1 = __builtin_amdgcn_permlane32_swap(a1, b1, false, false); \
        u32x4 w = {r0[0], r1[0], r0[1], r1[1]}; OUT = *reinterpret_cast<bf16x8*>(&w); } while (0)
    PK4(p0, 0, pa0); PK4(p0, 8, pa1); PK4(p1, 0, pa2); PK4(p1, 8, pa3);
#undef PK4
}
template <int KB>
__device__ __forceinline__ void qkt(f32x16& p0, f32x16& p1, const char* K_lds, int r32, int hi, const bf16x8* qr) {
    p0 = f32x16{}; p1 = f32x16{};
    const char* kb[4];
#pragma unroll
    for (int dd = 0; dd < 4; ++dd) kb[dd] = K_lds + KB * SHM_K + KSWZ(r32, (dd * 16 + hi * 8) * 2);
#pragma unroll
    for (int d0 = 0; d0 < 8; ++d0) { const char* a = kb[d0 & 3] + (d0 >> 2) * 128;
        bf16x8 b0 = *reinterpret_cast<const bf16x8*>(a);
        bf16x8 b1 = *reinterpret_cast<const bf16x8*>(a + 32 * 256);
        p0 = __builtin_amdgcn_mfma_f32_32x32x16_bf16(b0, qr[d0], p0, 0, 0, 0);
        p1 = __builtin_amdgcn_mfma_f32_32x32x16_bf16(b1, qr[d0], p1, 0, 0, 0); }
}
template <int VB>
__device__ __forceinline__ void pv_tile(f32x16* o, int vb0, bf16x8 pa0, bf16x8 pa1, bf16x8 pa2, bf16x8 pa3) {
#define TRRD(dst, off) asm volatile("ds_read_b64_tr_b16 %0, %1 offset:%2" : "=&v"(dst) : "v"(vb0), "i"(off) : "memory")
#define PV_D0(d0) do { s16x4 l0, l1, l2, l3, h0, h1, h2, h3; constexpr int b_ = VB * SHM_V + v_rd_off(d0, 0, 0); \
        TRRD(l0, b_); TRRD(h0, b_ + 2048); TRRD(l1, b_ + 4096); TRRD(h1, b_ + 6144); TRRD(l2, b_ + 8192); TRRD(h2, b_ + 10240); TRRD(l3, b_ + 12288); TRRD(h3, b_ + 14336); \
        asm volatile("s_waitcnt lgkmcnt(0)" ::: "memory"); SBAR();   \
        o[d0] = __builtin_amdgcn_mfma_f32_32x32x16_bf16(pa0, (bf16x8){l0[0], l0[1], l0[2], l0[3], h0[0], h0[1], h0[2], h0[3]}, o[d0], 0, 0, 0);   \
        o[d0] = __builtin_amdgcn_mfma_f32_32x32x16_bf16(pa1, (bf16x8){l1[0], l1[1], l1[2], l1[3], h1[0], h1[1], h1[2], h1[3]}, o[d0], 0, 0, 0);   \
        o[d0] = __builtin_amdgcn_mfma_f32_32x32x16_bf16(pa2, (bf16x8){l2[0], l2[1], l2[2], l2[3], h2[0], h2[1], h2[2], h2[3]}, o[d0], 0, 0, 0);   \
        o[d0] = __builtin_amdgcn_mfma_f32_32x32x16_bf16(pa3, (bf16x8){l3[0], l3[1], l3[2], l3[3], h3[0], h3[1], h3[2], h3[3]}, o[d0], 0, 0, 0); } while (0)
    PV_D0(0); PV_D0(1); PV_D0(2); PV_D0(3);
#undef PV_D0
#undef TRRD
}
struct BlockRef { const bf16* Q; const bf16* K; const bf16* V; bf16* O; int P0; };
struct Seam { bf16x8 qr[8]; bf16x8 st_v0, st_v1, st_k0, st_k1; };
constexpr int LDO = 2048;
#define ROW(p, k0, rr) ((p) + (size_t)((k0) + (rr)) * D + sc)
#define VMW() asm volatile("s_waitcnt vmcnt(0)" ::: "memory")
#define VMWN(n) asm volatile("s_waitcnt vmcnt(%0)" :: "i"(n) : "memory")
#define SLOAD_H(Kp, Vp, k0) do { S.st_v0 = load8(ROW(Vp, k0, sr_)); S.st_v1 = load8(ROW(Vp, k0, 32 + sr_));              \
                         S.st_k0 = load8(ROW(Kp, k0, sr_)); S.st_k1 = load8(ROW(Kp, k0, 32 + sr_)); } while (0)
#define SWRITE_HK(bf) do { *(bf16x8*)(K_lds + (bf) * SHM_K + kws) = S.st_k0; *(bf16x8*)(K_lds + (bf) * SHM_K + kws + 32 * 256) = S.st_k1; } while (0)
#define SWRITE_HV(bf) do { *(bf16x8*)(V_lds + (bf) * SHM_V + vst0) = S.st_v0; *(bf16x8*)(V_lds + (bf) * SHM_V + vst1) = S.st_v1; } while (0)
#define SWRITE_H(bf) do { SWRITE_HV(bf); SWRITE_HK(bf); } while (0)
__device__ __forceinline__ void moba_prime(const BlockRef& cur, char* lds, Seam& S, const int wid) {
    const int lane = lane_id_opaque(), tid = wid * 64 + lane, r32 = lane & 31, hi = lane >> 5;
    const int sr_ = tid >> 4, sc = (tid & 15) * 8, kws = KSWZ(sr_, sc * 2); char* K_lds = lds + 2 * SHM_V;
    for (int d0 = 0; d0 < 8; ++d0) S.qr[d0] = load8(cur.Q + (size_t)(wid * QBLK + r32) * D + d0 * 16 + hi * 8);
    SLOAD_H(cur.K, cur.V, 0); VMW(); SWRITE_HK(0);
    __syncthreads();
}
__device__ __forceinline__ void moba_block(const BlockRef& cur, const BlockRef& nxt, char* lds, Seam& S, int blk, float sr, const float* kmean_g, const int wid) {
    const int lane = lane_id_opaque(), tid = wid * 64 + lane, r32 = lane & 31, hi = lane >> 5;
    const int NT = cur.P0 / KVBLK + 4;
    const int qlo = cur.P0 + wid * QBLK, qm = qlo + r32 - 4 * hi;
    char* V_lds = lds; char* K_lds = lds + 2 * SHM_V;
    float* ws = (float*)(lds + 2 * SHM_V + 2 * SHM_K) + wid * 64; float* li_l = ws, * al_l = ws + 32;
    unsigned selmask = (1u << blk) - 1u;
#ifdef EXP_NOGATE
    if (blk > 3) selmask = 7u;
    if (false) {
#else
    if (blk > 3) {
#endif
        float* KM = (float*)(lds + KM_OFF);
        if (tid < 256) ((f32x4*)KM)[tid] = ((const f32x4*)kmean_g)[tid];
        __syncthreads();
        float g[7];
#pragma unroll
        for (int n = 0; n < 7; ++n) g[n] = -__builtin_inff();
#pragma unroll
        for (int n = 0; n < 7; ++n) {
            if (n < blk) {
                float a0 = 0.f, a1 = 0.f;
#pragma unroll
                for (int d0 = 0; d0 < 8; ++d0) {
                    const u32x4 qw = *reinterpret_cast<const u32x4*>(&S.qr[d0]);
                    const f32x4 k0 = *(const f32x4*)(KM + n * 128 + d0 * 16 + hi * 8), k1 = *(const f32x4*)(KM + n * 128 + d0 * 16 + hi * 8 + 4);
                    a0 = fmaf(__uint_as_float(qw[0] << 16), k0[0], a0); a1 = fmaf(__uint_as_float(qw[0] & 0xffff0000u), k0[1], a1);
                    a0 = fmaf(__uint_as_float(qw[1] << 16), k0[2], a0); a1 = fmaf(__uint_as_float(qw[1] & 0xffff0000u), k0[3], a1);
                    a0 = fmaf(__uint_as_float(qw[2] << 16), k1[0], a0); a1 = fmaf(__uint_as_float(qw[2] & 0xffff0000u), k1[1], a1);
                    a0 = fmaf(__uint_as_float(qw[3] << 16), k1[2], a0); a1 = fmaf(__uint_as_float(qw[3] & 0xffff0000u), k1[3], a1); }
                float a = a0 + a1;
                auto rr = __builtin_amdgcn_permlane32_swap(__float_as_uint(a), __float_as_uint(a), false, false);
                g[n] = __uint_as_float(rr[0]) + __uint_as_float(rr[1]);
            }
        }
        selmask = 0u;
#pragma unroll
        for (int n = 0; n < 7; ++n) {
            int rank = 0;
#pragma unroll
            for (int m2 = 0; m2 < 7; ++m2) { if (m2 != n) rank += (g[m2] > g[n] || (g[m2] == g[n] && m2 < n)) ? 1 : 0; }
            if (n < blk && rank < 3) selmask |= (1u << n);
        }
    }
    float m_reg = -1e30f, l_reg = 0; f32x16 o[4] = {};
    const int sr_ = tid >> 4, sc = (tid & 15) * 8, vst0 = v_st(sr_, sc), vst1 = v_st(32 + sr_, sc), kws = KSWZ(sr_, sc * 2);
    const int vb0 = (int)(uintptr_t)V_lds + v_rd_base(lane);
    const bf16* Kh = cur.K; const bf16* Vh = cur.V;
#define RESC(a) do { if (__any((a) < 1.f)) { if (hi == 0) al_l[r32] = (a); asm volatile("s_waitcnt lgkmcnt(0)" ::: "memory");              \
                     for (int d_ = 0; d_ < 4; ++d_) for (int r = 0; r < 16; ++r) o[d_][r] *= al_l[crow(r, hi)]; } } while (0)
#define KBASE(t) ((t) * KVBLK)
#define MASKT(P0_, P1_, t) moba_mask(P0_, P1_, KBASE(t), qm, blk, selmask, sr)
    constexpr int NQL = 8;
#define SEAM_K0() do { VMWN(NQL); SWRITE_HK(0); SBAR(); } while (0)
    f32x16 pA0, pA1, pB0, pB1; float mnA, mnB, alA, alB; bf16x8 pa0, pa1, pa2, pa3;
    SWRITE_HV(0); SBAR();
    if (NT > 1) { SLOAD_H(Kh, Vh, KBASE(1)); }
    SBAR(); qkt<0>(pA0, pA1, K_lds, r32, hi, S.qr);
    MASKT(pA0, pA1, 0); partialSM(pA0, pA1, m_reg, mnA, alA);
    if (NT > 1) { VMW(); SWRITE_H(1); }
    __syncthreads();
#define HALF_STEP(PX0, PX1, mnX, alX, PY0, PY1, alY, t, KB, VB, SB) do {                                                      \
        SBAR(); qkt<KB>(PX0, PX1, K_lds, r32, hi, S.qr);                                             \
        finishSM(PY0, PY1, alY, l_reg, pa0, pa1, pa2, pa3); SBAR();                                                           \
        if ((t) + 1 < NT) { SLOAD_H(Kh, Vh, KBASE((t) + 1)); SBAR(); }                                               \
        pv_tile<VB>(o, vb0, pa0, pa1, pa2, pa3); MASKT(PX0, PX1, (t)); partialSM(PX0, PX1, m_reg, mnX, alX);                                        \
        __syncthreads();                                                                                                      \
        if ((t) + 1 < NT) { VMW(); SWRITE_H(SB); }                                                                          \
        RESC(alX); __syncthreads(); } while (0)
    for (int t = 1; t + 1 < NT; t += 2) {
        HALF_STEP(pB0, pB1, mnB, alB, pA0, pA1, alA, t, 1, 0, 0);
        HALF_STEP(pA0, pA1, mnA, alA, pB0, pB1, alB, t + 1, 0, 1, 1);
    }
    const bool even = (NT & 1) == 0;
    if (even) { SBAR(); qkt<1>(pB0, pB1, K_lds, r32, hi, S.qr); SBAR(); }
    { SLOAD_H(nxt.K, nxt.V, 0); SBAR();
#pragma unroll
        for (int d0 = 0; d0 < 8; ++d0) S.qr[d0] = load8(nxt.Q + (size_t)(wid * QBLK + r32) * D + d0 * 16 + hi * 8); }
    SBAR();
    finishSM(pA0, pA1, alA, l_reg, pa0, pa1, pa2, pa3); SBAR();
    pv_tile<0>(o, vb0, pa0, pa1, pa2, pa3);
    if (even) { MASKT(pB0, pB1, NT - 1); partialSM(pB0, pB1, m_reg, mnB, alB); __syncthreads(); RESC(alB);
        finishSM(pB0, pB1, alB, l_reg, pa0, pa1, pa2, pa3); SBAR(); pv_tile<1>(o, vb0, pa0, pa1, pa2, pa3); }
    SBAR(); SEAM_K0();
    if (hi == 0) li_l[r32] = l_reg; asm volatile("s_waitcnt lgkmcnt(0)" ::: "memory");
    float rli[16];
#pragma unroll
    for (int r = 0; r < 16; ++r) rli[r] = __builtin_amdgcn_rcpf(li_l[crow(r, hi)]);
    bf16* Ow = cur.O + (size_t)(wid * QBLK) * LDO;
#pragma unroll
    for (int r = 0; r < 16; ++r) { const int orow = crow(r, hi);
#pragma unroll
        for (int d0 = 0; d0 < 4; ++d0) { const float v = o[d0][r] * rli[r];
            const float vn = dppx<0xB1>(v);
            if ((r32 & 1) == 0) *(unsigned*)(Ow + (size_t)orow * LDO + d0 * 32 + r32) = cvtpk(v, vn); } }
    __syncthreads();
#undef RESC
#undef KBASE
#undef MASKT
#undef SEAM_K0
#undef HALF_STEP
}
#undef ROW
#undef VMW
#undef VMWN
#undef SLOAD_H
#undef SWRITE_HK
#undef SWRITE_HV
#undef SWRITE_H
}

#define GAS __attribute__((address_space(1)))
#define LAS __attribute__((address_space(3)))
typedef unsigned short bf16;
typedef unsigned v4u __attribute__((ext_vector_type(4)));
typedef unsigned v2u __attribute__((ext_vector_type(2)));
typedef float f32x4 __attribute__((ext_vector_type(4)));
typedef float f32x2 __attribute__((ext_vector_type(2)));
typedef GAS unsigned gu32;
#define RLX_AGENT __ATOMIC_RELAXED, __HIP_MEMORY_SCOPE_AGENT
#define LDS_WAIT() asm volatile("s_waitcnt lgkmcnt(0)" ::: "memory")

constexpr int NWAVES = 8, NTHREADS = 512;
constexpr int BATCH = 8, SEQ = 2048, DM = 2048, M = BATCH * SEQ;
constexpr int NPROJ = 6656;
constexpr int DFF = 5632, NUP = 2 * DFF;
constexpr int KLORA = 384, NLORA = 4096;
constexpr int N_IN = 59;
constexpr float RMS_EPS = 1e-6f, GN_EPS = 64e-5f;

constexpr size_t MiB = 1u << 20;
constexpr size_t WS_CTL = 0, CTL_ZERO_BYTES = 2 * MiB;
constexpr size_t WS_RS = 2 * MiB;
constexpr size_t WS_WMIX = 8 * MiB, WS_WOUT = 34 * MiB, WS_WUP = 42 * MiB, WS_WDN = 86 * MiB, WS_WLORA = 108 * MiB;
constexpr size_t WS_XB = 112 * MiB;
constexpr size_t WS_VFIRST = 176 * MiB;
constexpr size_t WS_R0 = 208 * MiB;
constexpr size_t WS_U = WS_R0, WS_HALO = WS_R0, WS_ACT = WS_R0 + 352 * MiB;
constexpr size_t WS_PROJ = WS_R0, WS_QN = WS_R0 + 208 * MiB, WS_KN = WS_QN + 32 * MiB, WS_VV = WS_KN + 32 * MiB, WS_KMEAN = WS_VV + 32 * MiB,
                 WS_ZACT = WS_KMEAN + 1 * MiB, WS_SR = WS_ZACT + 12 * MiB, WS_SK = WS_SR + 32 * MiB, WS_SV = WS_SK + 32 * MiB, WS_SA = WS_SV + 32 * MiB,
                 WS_SB = WS_SA + 32 * MiB, WS_LD = WS_SB + 32 * MiB, WS_G = WS_LD + 64 * MiB, WS_YCAT = WS_G + 32 * MiB, WS_MIX_END = WS_YCAT + 64 * MiB;
constexpr size_t WS_H = WS_R0, WS_CV = WS_R0 + 208 * MiB, WS_HALO2 = WS_R0 + 280 * MiB, WS_MB = WS_R0 + 288 * MiB;
constexpr size_t WS_WALT = WS_R0 + 32 * MiB;
constexpr size_t WB_ODD = WS_WALT - WS_WMIX;
constexpr size_t WS_P0 = WS_SR, WS_P1 = WS_SV, WS_P2 = WS_SB, WS_P3 = WS_SB + 64 * MiB;
constexpr size_t WS_PCH = WS_MIX_END, WS_BON = WS_MIX_END + 4 * MiB;
constexpr size_t WS_END = WS_MIX_END + 5 * MiB;
static_assert(WS_ACT + (size_t)M * DFF * 2 <= WS_END && WS_MB + (size_t)M * DM * 2 <= WS_ACT && WS_WALT + 104 * MiB <= WS_CV && WS_R0 + 24 * MiB <= WS_WALT, "d_ws map");
constexpr int CW_BAR = 4096, CW_QUEUE = 8192, CW_DBG = 12288;
constexpr int RING_BYTES = 131072, XCH_OFF = RING_BYTES, MISC_OFF = RING_BYTES + 8192, TAP_OFF = RING_BYTES + 16384, LDS_BYTES = 155648;

#define XB_TMO      128
#define XB_XCNT(j)  (256  + 64 * (j))
#define XB_XSUB(j)  (1280 + 64 * (j))
#define XB_XGEN(j)  (2304 + 64 * (j))
#define XB_TOP      3328
#define XB_TOPGEN   3392
#define XCD_BAR_WORDS 3456
#define XB_SPIN_CAP (1u << 18)
__device__ __forceinline__ unsigned xb_ld(unsigned* p)              { return __hip_atomic_load(p, __ATOMIC_RELAXED, __HIP_MEMORY_SCOPE_AGENT); }
__device__ __forceinline__ unsigned xb_add(unsigned* p, unsigned v) { return __hip_atomic_fetch_add(p, v, __ATOMIC_RELAXED, __HIP_MEMORY_SCOPE_AGENT); }
__device__ __forceinline__ unsigned xb_xcc_id() { return (unsigned)__builtin_amdgcn_s_getreg((3 << 11) | 20) & 0xFu; }
#define XB_SPIN(cond, bar) do { unsigned _sp = 0; while (cond) { __builtin_amdgcn_s_sleep(1); \
    if ((++_sp & 255u) == 0u) { if (xb_ld(&(bar)[XB_TMO])) break; if (_sp > XB_SPIN_CAP) { atomicAdd(&(bar)[XB_TMO], 1u); break; } } } } while (0)
struct XcdBarrier { unsigned* bar; unsigned x; volatile LAS unsigned* st; };
__device__ __forceinline__ XcdBarrier xcd_barrier_post(unsigned* bar, volatile LAS unsigned* st) {
    XcdBarrier b; b.bar = bar; b.x = xb_xcc_id(); b.st = st;
    if (threadIdx.x == 0) (void)xb_add(&bar[XB_XCNT(b.x)], 1u);
    return b;
}
__device__ __forceinline__ void xcd_barrier_complete(unsigned* bar, unsigned x, unsigned& nloc, unsigned& nx) {
    const unsigned G = gridDim.x * gridDim.y * gridDim.z;
    unsigned sum, cnt, mine, sp = 0u;
    for (;;) {
        sum = 0u; cnt = 0u; mine = 0u;
#pragma unroll
        for (unsigned j = 0; j < 16; ++j) { const unsigned c = xb_ld(&bar[XB_XCNT(j)]); sum += c; cnt += (c > 0u) ? 1u : 0u; mine = (j == x) ? c : mine; }
        if (sum == G) break;
        __builtin_amdgcn_s_sleep(1);
        if ((++sp & 255u) == 0u) { if (xb_ld(&bar[XB_TMO])) break; if (sp > XB_SPIN_CAP) { atomicAdd(&bar[XB_TMO], 1u); break; } }
    }
    nloc = mine > 0u ? mine : 1u; nx = cnt > 0u ? cnt : 1u;
}
__device__ __forceinline__ void xcd_barrier(const XcdBarrier& b) {
    asm volatile("s_waitcnt vmcnt(0)" ::: "memory");
    __syncthreads();
    if (threadIdx.x == 0) {
        unsigned* bar = b.bar; unsigned bx = b.x;
        asm volatile("" : "+s"(bar), "+s"(bx));
        __builtin_amdgcn_s_waitcnt(0);
        unsigned nloc = b.st[0], nx = b.st[1];
        if (nloc == 0u) { xcd_barrier_complete(bar, bx, nloc, nx); b.st[0] = nloc; b.st[1] = nx; }
        const unsigned old = xb_add(&bar[XB_XSUB(bx)], 1u);
        const unsigned gen = old / nloc;
        if (old + 1u == (gen + 1u) * nloc) {
            __builtin_amdgcn_fence(__ATOMIC_RELEASE, "agent");
            asm volatile("s_waitcnt vmcnt(0)" ::: "memory");
            const unsigned og = xb_add(&bar[XB_TOP], 1u);
            const unsigned tgt = (og / nx + 1u) * nx;
            if (og + 1u != tgt) XB_SPIN(xb_ld(&bar[XB_TOP]) < tgt, bar);
            __builtin_amdgcn_fence(__ATOMIC_ACQUIRE, "agent");
            asm volatile("s_waitcnt vmcnt(0)" ::: "memory");
        } else {
            const unsigned tgt = (gen + 1u) * nx;
            XB_SPIN(xb_ld(&bar[XB_TOP]) < tgt, bar);
            __builtin_amdgcn_fence(__ATOMIC_ACQUIRE, "agent");
            asm volatile("s_waitcnt vmcnt(0)" ::: "memory");
        }
    }
    __syncthreads();
}

__device__ __forceinline__ unsigned pk2(float lo, float hi) { return pg8::cvt_pk_bf16(lo, hi); }
__device__ __forceinline__ float bflo(unsigned u) { return __uint_as_float(u << 16); }
__device__ __forceinline__ float bfhi(unsigned u) { return __uint_as_float(u & 0xffff0000u); }
template <int CTRL> __device__ __forceinline__ float dpp(float x) { return __builtin_bit_cast(float, __builtin_amdgcn_mov_dpp(__builtin_bit_cast(int, x), CTRL, 0xf, 0xf, true)); }
__device__ __forceinline__ float sum8(float x)  { x += dpp<0xB1>(x); x += dpp<0x4E>(x); x += dpp<0x141>(x); return x; }
__device__ __forceinline__ float sum16(float x) { x = sum8(x); x += dpp<0x128>(x); return x; }
__device__ __forceinline__ unsigned short bf1(float x) { return (unsigned short)(pk2(x, 0.f) & 0xffffu); }
__device__ __forceinline__ float sigm(float x) { return __builtin_amdgcn_rcpf(1.0f + __expf(-x)); }
__device__ __forceinline__ void unpack8(v4u w, float (&f)[8]) { f[0] = bflo(w.x); f[1] = bfhi(w.x); f[2] = bflo(w.y); f[3] = bfhi(w.y); f[4] = bflo(w.z); f[5] = bfhi(w.z); f[6] = bflo(w.w); f[7] = bfhi(w.w); }
__device__ __forceinline__ v4u pack8(const float (&f)[8]) { v4u w; w.x = pk2(f[0], f[1]); w.y = pk2(f[2], f[3]); w.z = pk2(f[4], f[5]); w.w = pk2(f[6], f[7]); return w; }

constexpr int CV_P = 129, CV_TILE = 64 * CV_P;
struct ConvP { const float *norm_mix, *w_mix, *w_out, *norm_ffn, *ffn_up, *ffn_down, *w_lora, *a_lora, *g_lora, *v_lora, *a0, *v0; };
struct CvItem { const float* W; const float* gain; bf16* WT; int ldw, K, nsrc, kb, drow0, scol0; };
__device__ __forceinline__ bool cv_decode(int it, const ConvP& P, int li, unsigned char* ws, CvItem& c, int bid_, int nwg_) {
    const bool even = (li & 1) == 0; if (!even) ws += WB_ODD;
    const int nsrc = even ? (li == 0 ? 6432 : 6464) : 6144, nb_mix = even ? NPROJ / 128 : 48;
    const int I_MIX = 32 * nb_mix, I_OUT = 32 * 16, I_UP = 32 * (NUP / 128), I_DN = (DFF / 64) * 16;
    int r = it;
    if (r < I_MIX) { c.W = P.w_mix; c.gain = P.norm_mix; c.WT = (bf16*)(ws + WS_WMIX); c.ldw = nsrc; c.K = DM; c.nsrc = nsrc; c.kb = r / nb_mix; const int nb = r % nb_mix; c.drow0 = 128 * nb; c.scol0 = even ? 128 * nb : (nb < 32 ? ((nb & 1) ? 4096 : 2048) + 128 * (nb >> 1) : 128 * (nb - 32)); return true; } r -= I_MIX;
    if (r < I_OUT) { c.W = P.w_out; c.gain = nullptr; c.WT = (bf16*)(ws + WS_WOUT); c.ldw = DM; c.K = DM; c.nsrc = DM; c.kb = r / 16; const int nb = r % 16; c.drow0 = 128 * nb; c.scol0 = 128 * nb; return true; } r -= I_OUT;
    if (r < I_UP) { const int nbu = NUP / 128, nb = r % nbu; c.W = P.ffn_up; c.gain = P.norm_ffn; c.WT = (bf16*)(ws + WS_WUP); c.ldw = NUP; c.K = DM; c.nsrc = NUP; c.kb = r / nbu; c.drow0 = 128 * nb;
        c.scol0 = (nb & 1) ? DFF + 128 * (nb >> 1) : 128 * (nb >> 1); return true; } r -= I_UP;
    if (r < I_DN) { c.W = P.ffn_down; c.gain = nullptr; c.WT = (bf16*)(ws + WS_WDN); c.ldw = DM; c.K = DFF; c.nsrc = DM; c.kb = r / 16; const int nb = r % 16; c.drow0 = 128 * nb; c.scol0 = 128 * nb; return true; }
    return false;
}
__device__ __forceinline__ void cv_load(const CvItem& c, int tid, f32x4 (&v)[4]) {
#pragma unroll
    for (int j = 0; j < 4; ++j) { const int i = tid + 512 * j, row = i >> 5, col = (i & 31) * 4;
        v[j] = (c.scol0 + col < c.nsrc) ? *(const f32x4*)(c.W + (size_t)(c.kb * 64 + row) * c.ldw + c.scol0 + col) : (f32x4){0.f, 0.f, 0.f, 0.f}; }
}
__device__ __forceinline__ void convert_layer(const ConvP P, int li, unsigned char* ws, LAS unsigned char* lds, int wave, int lane, int tid, int bid_, int nwg_, int it0, int it1, int step, bool do_lora) {
    LAS float* T = (LAS float*)lds;
    const bool even = (li & 1) == 0;
#define CV_WRITE(v_, t_) do { _Pragma("unroll") for (int j = 0; j < 4; ++j) { const int i = tid + 512 * j, row = i >> 5, col = (i & 31) * 4; LAS float* p = (t_) + row * CV_P + col; p[0] = v_[j][0]; p[1] = v_[j][1]; p[2] = v_[j][2]; p[3] = v_[j][3]; } } while (0)
#define CV_XPOSE(c_, t_) do { _Pragma("unroll") for (int j = 0; j < 2; ++j) { const int q = tid + 512 * j, n = q >> 3, c = q & 7; const LAS float* s = (t_) + (8 * c) * CV_P + n; \
            float f[8]; \
            _Pragma("unroll") for (int e = 0; e < 8; ++e) f[e] = s[e * CV_P]; \
            if (c_.gain) { const f32x4 g0 = *(const f32x4*)(c_.gain + c_.kb * 64 + 8 * c), g1 = *(const f32x4*)(c_.gain + c_.kb * 64 + 8 * c + 4); \
                f[0] *= g0[0]; f[1] *= g0[1]; f[2] *= g0[2]; f[3] *= g0[3]; f[4] *= g1[0]; f[5] *= g1[1]; f[6] *= g1[2]; f[7] *= g1[3]; } \
            *(v4u*)(c_.WT + (size_t)(c_.drow0 + n) * c_.K + c_.kb * 64 + 8 * c) = pack8(f); } } while (0)
    CvItem c0, c1, cc; f32x4 va[4], vb[4];
    int it = it0, buf = 0;
    bool h0 = it < it1 && cv_decode(it, P, li, ws, c0, bid_, nwg_);
    if (h0) cv_load(c0, tid, va);
    it += step;
    bool h1 = h0 && it < it1 && cv_decode(it, P, li, ws, c1, bid_, nwg_);
    if (h1) cv_load(c1, tid, vb);
    while (h0) {
        { LAS float* t = T + buf * CV_TILE; CV_WRITE(va, t); LDS_WAIT(); __syncthreads();
          cc = c0; it += step;
          const bool hn = h1 && it < it1 && cv_decode(it, P, li, ws, c0, bid_, nwg_);
          if (hn) cv_load(c0, tid, va);
          CV_XPOSE(cc, t); buf ^= 1; h0 = hn; }
        if (!h1) break;
        { LAS float* t = T + buf * CV_TILE; CV_WRITE(vb, t); LDS_WAIT(); __syncthreads();
          cc = c1; it += step;
          const bool hn = h0 && it < it1 && cv_decode(it, P, li, ws, c1, bid_, nwg_);
          if (hn) cv_load(c1, tid, vb);
          CV_XPOSE(cc, t); buf ^= 1; h1 = hn; }
    }
#undef CV_WRITE
#undef CV_XPOSE
    __syncthreads();
    if (even && do_lora) {
        const int gt = bid_ * NTHREADS + tid, NGT = nwg_ * NTHREADS;
        bf16* Wlora = (bf16*)(ws + WS_WLORA);
        for (int i = gt; i < NLORA * (KLORA / 8); i += NGT) {
            const int row = i / (KLORA / 8), k8 = (i % (KLORA / 8)) * 8, h = row >> 8, c = row & 255;
            const int q = 2 * (c >> 7) + ((c >> 4) & 1), chn = 64 * h + 16 * ((c >> 5) & 3) + 4 * ((c >> 2) & 3) + (c & 3);
            const float* src = nullptr; int koff = 0;
            if (q == 0 && k8 < 64) { src = P.w_lora; koff = 0; }
            else if (q == 1 && k8 >= 64 && k8 < 128) { src = P.a_lora; koff = 64; }
            else if (q == 2 && k8 >= 128 && k8 < 288) { src = P.g_lora; koff = 128; }
            else if (q == 3 && k8 >= 288 && k8 < 320) { src = P.v_lora; koff = 288; }
            float f[8];
#pragma unroll
            for (int e = 0; e < 8; ++e) f[e] = src ? src[(size_t)(k8 - koff + e) * 1024 + chn] : 0.f;
            if (k8 == 320) { if (q == 1) f[0] = P.a0[chn]; else if (q == 3 && P.v0) f[0] = P.v0[chn]; }
            *(v4u*)(Wlora + (size_t)row * KLORA + k8) = pack8(f);
        }
    }
}

struct Args { const float* in[N_IN]; float* out; unsigned char* ws; int ph_lo, ph_hi; };
constexpr int PH_PER_LAYER = 9, N_PHASES = 1 + 4 * PH_PER_LAYER;

__device__ __forceinline__ void prologue_rows(const float* x, bf16* xb, float* rs0, int wave, int lane, int bid_, int nwg_) {
    const int gw = bid_ * NWAVES + wave, NGW = nwg_ * NWAVES;
    for (int m = gw; m < M; m += 2 * NGW) {
        const int m1 = (m + NGW < M) ? m + NGW : m;
        const f32x4* xr0 = (const f32x4*)(x + (size_t)m * DM) + lane; const f32x4* xr1 = (const f32x4*)(x + (size_t)m1 * DM) + lane; f32x4 v[2][8];
#pragma unroll
        for (int j = 0; j < 8; ++j) { v[0][j] = xr0[64 * j]; v[1][j] = xr1[64 * j]; }
#pragma unroll
        for (int r = 0; r < 2; ++r) { if (r == 1 && m1 == m) break; const int mr = r ? m1 : m; float s = 0.f;
#pragma unroll
            for (int j = 0; j < 8; ++j) s += (v[r][j].x * v[r][j].x + v[r][j].y * v[r][j].y) + (v[r][j].z * v[r][j].z + v[r][j].w * v[r][j].w);
            s = asum64(s);
            v2u* ob = (v2u*)(xb + (size_t)mr * DM) + lane;
#pragma unroll
            for (int j = 0; j < 8; ++j) { v2u w; w.x = pk2(v[r][j].x, v[r][j].y); w.y = pk2(v[r][j].z, v[r][j].w); ob[64 * j] = w; }
            if (lane < 8) rs0[(size_t)mr * 8 + lane] = lane == 0 ? s : 0.f; }
    }
}

__device__ __forceinline__ void ld8f(const float* p, float (&o)[8]) { typedef float f4g __attribute__((ext_vector_type(4)));
    const __attribute__((address_space(1))) f4g* q = (const __attribute__((address_space(1))) f4g*)(uintptr_t)p; const f4g a = q[0], b = q[1];
    o[0] = a[0]; o[1] = a[1]; o[2] = a[2]; o[3] = a[3]; o[4] = b[0]; o[5] = b[1]; o[6] = b[2]; o[7] = b[3]; }
__device__ __forceinline__ void prep_phase(const float* q_gain, const float* k_gain, const float* shift_mu, bool has_v, unsigned char* ws, LAS unsigned char* lds, int wave, int lane, int tid, int bid_, int nwg_) {
    const bf16* proj = (const bf16*)(ws + WS_PROJ);
    bf16* QN = (bf16*)(ws + WS_QN); bf16* KN = (bf16*)(ws + WS_KN); bf16* VV = (bf16*)(ws + WS_VV); float* KMEAN = (float*)(ws + WS_KMEAN);
    {
        LAS float* red = (LAS float*)lds;
        const int c8 = (lane & 15) * 8, rsub = lane >> 4;
        for (int up = bid_; up < 256; up += nwg_) {
            const int unit = up * 2 + (wave >> 2);
            const bf16* kp = KN + ((size_t)(unit >> 3) * SEQ + (unit & 7) * 256 + (wave & 3) * 64 + rsub) * 128 + c8;
            v4u kw[16];
#pragma unroll
            for (int r = 0; r < 16; ++r) kw[r] = *(const v4u*)(kp + (size_t)r * 4 * 128);
            float kcol[8];
#pragma unroll
            for (int e = 0; e < 8; ++e) kcol[e] = 0.f;
#pragma unroll
            for (int r = 0; r < 16; ++r) { float kf[8]; unpack8(kw[r], kf);
#pragma unroll
                for (int e = 0; e < 8; ++e) kcol[e] += kf[e]; }
#pragma unroll
            for (int e = 0; e < 8; ++e) kcol[e] = xsum_rows4(kcol[e]);
            if (lane < 16) {
#pragma unroll
                for (int e = 0; e < 8; ++e) red[wave * 128 + c8 + e] = kcol[e]; }
            LDS_WAIT(); __syncthreads();
            if (tid < 256) { const int w4 = (tid >> 7) * 4, col = tid & 127;
                KMEAN[(size_t)(up * 2 + (tid >> 7)) * 128 + col] = ((red[w4 * 128 + col] + red[(w4 + 1) * 128 + col]) + (red[(w4 + 2) * 128 + col] + red[(w4 + 3) * 128 + col])) * (1.0f / 256.0f); }
            __syncthreads();
        }
    }
    bf16* ZACT = (bf16*)(ws + WS_ZACT);
    const int gt = bid_ * NTHREADS + tid, NGT = nwg_ * NTHREADS;
    for (int i0 = gt; i0 < M * 48; i0 += 6 * NGT) {
        v4u cw[6], pw[6];
#pragma unroll
        for (int q = 0; q < 6; ++q) { const int i = (i0 + q * NGT < M * 48) ? i0 + q * NGT : i0; const int tok = i / 48, k8 = (i % 48) * 8;
            const bf16* pr = proj + (size_t)tok * NPROJ + 6144 + k8;
            cw[q] = *(const v4u*)pr; pw[q] = *(const v4u*)((tok & (SEQ - 1)) ? pr - NPROJ : pr); }
#pragma unroll
        for (int q = 0; q < 6; ++q) { const int i = i0 + q * NGT; if (i >= M * 48) break; const int tok = i / 48, k8 = (i % 48) * 8;
            float f[8];
            if (k8 < 288 || (k8 < 320 && has_v)) {
                float c[8], p[8]; unpack8(cw[q], c);
                if ((tok & (SEQ - 1)) != 0) unpack8(pw[q], p); else {
#pragma unroll
                    for (int e = 0; e < 8; ++e) p[e] = 0.f; }
                float mu8[8]; ld8f(shift_mu + 3072 + k8, mu8);
#pragma unroll
                for (int e = 0; e < 8; ++e) { const float mu = mu8[e]; const float z = c[e] + mu * (p[e] - c[e]);
                    float a = z;
                    if (k8 < 64) a = 1.0f - 2.0f * __builtin_amdgcn_rcpf(1.0f + __expf(2.0f * z));
                    else if (k8 >= 128 && k8 < 288) a = sigm(z);
                    f[e] = a; }
            } else {
#pragma unroll
                for (int e = 0; e < 8; ++e) f[e] = 0.f;
                if (k8 == 320) f[0] = 1.0f; }
            *(v4u*)(ZACT + (size_t)tok * KLORA + k8) = pack8(f);
        }
    }
}

#ifndef DUP_IMG
#define DUP_IMG 1
#endif
#ifndef DUP_Y
#define DUP_Y 1
#endif
constexpr int SCAN_TB = 16, SCAN_NC = SEQ / SCAN_TB;
constexpr int SC_XB = 0, SC_YB = SC_XB + 2 * 32 * 144, SC_SB = SC_YB + 2 * 32 * 144, SC_ZT = SC_SB + 64 * 144, SC_UVT = SC_ZT + 2 * 64 * 80, SC_AM = SC_UVT + 2 * 64 * 80,
              SC_G = SC_AM + 2 * 32 * 80, SC_H = SC_G + 2 * 32 * 36 * 4, SC_YO = SC_H + 32 * 65 * 4, SC_PC = SC_YO + 16 * 64 * 4, SC_VF = SC_PC + 2 * 256, SC_END = SC_VF + 2 * 16 * 64 * 4;
static_assert(SC_END <= RING_BYTES, "scan LDS map");
typedef short sbf16x8 __attribute__((ext_vector_type(8)));
typedef float f32x16 __attribute__((ext_vector_type(16)));
__device__ __forceinline__ void scan_chain(int b, int h, const float* r_k, const float* gn_w, const float* gn_b, unsigned char* ws, LAS unsigned char* lds, const int wave) {
    const int lane = lane_id_opaque(), tid = wave * 64 + lane;
    LAS unsigned short* SBs = (LAS unsigned short*)(lds + SC_SB);
    LAS float* Hm = (LAS float*)(lds + SC_H);
    LAS float* YO = (LAS float*)(lds + SC_YO);
#define GM_(s)  ((LAS float*)(lds + SC_G + (s) * 4608))
#define XB_(s)  ((LAS unsigned short*)(lds + SC_XB + (s) * 4608))
#define YB_(s)  ((LAS unsigned short*)(lds + SC_YB + (s) * 4608))
#define ZT_(s)  ((LAS unsigned short*)(lds + SC_ZT + (s) * 5120))
#define UVT_(s) ((LAS unsigned short*)(lds + SC_UVT + (s) * 5120))
#define AM_(s)  ((LAS unsigned short*)(lds + SC_AM + (s) * 2560))
#define PC_(s)  ((LAS float*)(lds + SC_PC + (s) * 256))
#define VF_(s)  ((LAS float*)(lds + SC_VF + (s) * 4096))
    const int l31 = lane & 31, hh = lane >> 5;
    const int lt = tid >> 5, lc = (tid & 31) * 2;
    const unsigned cbase = (unsigned)b * (SEQ * 1024u) + 64u * h + lc;
    f32x16 S = {};
    for (int i = tid; i < 64 * 72 / 2; i += NTHREADS) ((LAS unsigned*)SBs)[i] = 0u;
    for (int i = tid; i < 2 * 32 * 40 / 2; i += NTHREADS) ((LAS unsigned*)(lds + SC_AM))[i] = 0u;
    v2u r0_, r1_, r3_; f32x2 rpc_ = (f32x2){0.f, 0.f};
    unsigned qv0 = 0u, qg0 = 0u, qv1 = 0u, qg1 = 0u; float qb0 = 0.f, qb1 = 0.f;
#define SCAN_LOAD(c) do { const unsigned tk_ = (unsigned)b * SEQ + (unsigned)(c) * SCAN_TB + lt; const unsigned o_ = cbase + ((unsigned)(c) * SCAN_TB + lt) * 1024u; \
        r0_ = *(const v2u*)(ws + (unsigned)(WS_P0 + 4u * o_)); r1_ = *(const v2u*)(ws + (unsigned)(WS_P1 + 4u * o_)); r3_ = *(const v2u*)(ws + (unsigned)(WS_P3 + 4u * o_)); \
        rpc_ = *(const f32x2*)(ws + (unsigned)(WS_PCH + 4u * ((tk_ >> 4) * 1024u + 64u * h + lc))); } while (0)
#define LOW2(w) (((w).x & 0xffffu) | ((w).y << 16))
#define HIGH2(w) (((w).x >> 16) | ((w).y & 0xffff0000u))
#define SCAN_IMG(set) do { LAS unsigned short* zt_ = ZT_(set); LAS unsigned short* uv_ = UVT_(set); \
        *(LAS unsigned*)(XB_(set) + lt * 72 + lc) = LOW2(r0_); *(LAS unsigned*)(XB_(set) + (16 + lt) * 72 + lc) = HIGH2(r0_); \
        *(LAS unsigned*)(YB_(set) + lt * 72 + lc) = LOW2(r1_); *(LAS unsigned*)(YB_(set) + (16 + lt) * 72 + lc) = HIGH2(r1_); \
        const int sw = ((lc >> 4) & 3) << 3, j0 = lt ^ sw, j1 = (16 + lt) ^ sw; \
        zt_[lc * 40 + j0] = bf1(bflo(r1_.x) * rpc_.x); zt_[(lc + 1) * 40 + j0] = bf1(bflo(r1_.y) * rpc_.y); zt_[lc * 40 + j1] = bf1(bfhi(r1_.x) * rpc_.x); zt_[(lc + 1) * 40 + j1] = bf1(bfhi(r1_.y) * rpc_.y); \
        uv_[lc * 40 + j1] = (unsigned short)(r3_.x & 0xffffu); uv_[(lc + 1) * 40 + j1] = (unsigned short)(r3_.y & 0xffffu); \
        *(LAS f32x2*)(VF_(set) + lt * 64 + lc) = (f32x2){bflo(r3_.x), bflo(r3_.y)}; \
        if (lt == 0) *(LAS f32x2*)(PC_(set) + lc) = rpc_; \
        qv0 = qv1; qg0 = qg1; qb0 = qb1; qv1 = LOW2(r3_); qg1 = HIGH2(r3_); qb1 = asum32(bfhi(r0_.x) * bfhi(r1_.x) * rk0 + bfhi(r0_.y) * bfhi(r1_.y) * rk1); } while (0)
#define SCAN_G(set) do { f32x16 acc = {}; LAS unsigned short* am_ = AM_(set); LAS float* Gm = GM_(set); \
        _Pragma("unroll") for (int s = 0; s < 4; ++s) { const sbf16x8 A = *(const LAS sbf16x8*)(XB_(set) + l31 * 72 + 16 * s + 8 * hh), B = *(const LAS sbf16x8*)(YB_(set) + l31 * 72 + 16 * s + 8 * hh); \
            acc = __builtin_amdgcn_mfma_f32_32x32x16_bf16(A, B, acc, 0, 0, 0); } \
        const int j = l31 & 15; \
        _Pragma("unroll") for (int r = 0; r < 16; ++r) { const int t = (r & 3) + 8 * (r >> 2) + 4 * hh; \
            if (r < 8) { const float gv = (j < t) ? acc[r] : 0.f; Gm[t * 36 + l31] = gv; } else { const float av = (j <= t - 16) ? acc[r] : 0.f; am_[(t - 16) * 40 + l31] = bf1(av); } } } while (0)
    const float gw0 = gn_w[64 * h + lc], gw1 = gn_w[64 * h + lc + 1], gb0 = gn_b[64 * h + lc], gb1 = gn_b[64 * h + lc + 1];
    const float rk0 = r_k[64 * h + lc], rk1 = r_k[64 * h + lc + 1];
    SCAN_LOAD(0);
#define SCAN_BAR() do { asm volatile("s_waitcnt lgkmcnt(0)" ::: "memory"); __builtin_amdgcn_s_barrier(); asm volatile("" ::: "memory"); } while (0)
    for (int bi = -1; bi < SCAN_NC; ++bi) {
        const int set = bi & 1, t0 = bi * SCAN_TB;
        if (bi >= 1) {
            const f32x2 yv = *(const LAS f32x2*)(YO + lt * 64 + lc);
            float sm = yv.x + yv.y;
            sm = asum32(sm);
            const float mean = sm * (1.0f / 64.0f), d0 = yv.x - mean, d1 = yv.y - mean;
            float vr = d0 * d0 + d1 * d1;
            vr = asum32(vr);
            const float rstd = rsqrtf(vr * (1.0f / 64.0f) + GN_EPS);
            const unsigned tok = (unsigned)b * SEQ + (t0 - SCAN_TB) + lt;
            const float o0 = (d0 * rstd * gw0 + gb0 + qb0 * bflo(qv0)) * bflo(qg0), o1 = (d1 * rstd * gw1 + gb1 + qb0 * bfhi(qv0)) * bfhi(qg0);
            *(unsigned*)(ws + (unsigned)(WS_YCAT + 2u * (tok * 2048u + 1024u + 64u * h + lc))) = pk2(o0, o1);
        }
        if (bi + 1 < SCAN_NC) { SCAN_IMG(set ^ 1); for (int di_ = 1; di_ < DUP_IMG; ++di_) { const unsigned a_ = qv0, b_ = qg0, c_ = qv1, e_ = qg1; const float f_ = qb0, g_ = qb1; SCAN_IMG(set ^ 1); qv0 = a_; qg0 = b_; qv1 = c_; qg1 = e_; qb0 = f_; qb1 = g_; } } else { qv0 = qv1; qg0 = qg1; qb0 = qb1; }
        if (bi + 2 < SCAN_NC) SCAN_LOAD(bi + 2);
        if (bi >= 0 && (wave == 1 || wave == 2)) {
            f32x16 acc = {};
#pragma unroll
            for (int s = 0; s < 4; ++s) { const sbf16x8 A = *(const LAS sbf16x8*)(XB_(set) + l31 * 72 + 16 * s + 8 * hh), B = *(const LAS sbf16x8*)(SBs + (32 * (wave - 1) + l31) * 72 + 16 * s + 8 * hh);
                acc = __builtin_amdgcn_mfma_f32_32x32x16_bf16(A, B, acc, 0, 0, 0); }
#pragma unroll
            for (int r = 0; r < 16; ++r) { const int t = (r & 3) + 8 * (r >> 2) + 4 * hh; Hm[t * 65 + 32 * (wave - 1) + l31] = acc[r]; }
        }
        SCAN_BAR();
        if (bi >= 0 && wave < 4) {
            const int vq = lane >> 4, t = lane & 15; const LAS float* Gm = GM_(set);
            f32x4 ga4[4], gk4[4]; float acc[4], vv[4];
#pragma unroll
            for (int q = 0; q < 4; ++q) { ga4[q] = *(const LAS f32x4*)(Gm + t * 36 + 4 * q); gk4[q] = *(const LAS f32x4*)(Gm + t * 36 + 16 + 4 * q); }
#pragma unroll
            for (int p = 0; p < 4; ++p) { const int v = 16 * wave + 4 * p + vq; acc[p] = Hm[t * 65 + v]; vv[p] = VF_(set)[t * 64 + v]; }
#define S3_STEP(j) do { const float gaj = ga4[(j) >> 2][(j) & 3], gkj = gk4[(j) >> 2][(j) & 3]; \
                _Pragma("unroll") for (int p = 0; p < 4; ++p) { const float uj = dppx<0x150 + (j)>(acc[p]), vj = dppx<0x150 + (j)>(vv[p]); acc[p] = fmaf(gaj, uj, fmaf(gkj, vj, acc[p])); } } while (0)
            S3_STEP(0); S3_STEP(1); S3_STEP(2); S3_STEP(3); S3_STEP(4); S3_STEP(5); S3_STEP(6); S3_STEP(7); S3_STEP(8); S3_STEP(9); S3_STEP(10); S3_STEP(11); S3_STEP(12); S3_STEP(13); S3_STEP(14);
#undef S3_STEP
#pragma unroll
            for (int p = 0; p < 4; ++p) { const int v = 16 * wave + 4 * p + vq; UVT_(set)[v * 40 + ((((t >> 3) ^ ((v >> 4) & 3))) << 3) + (t & 7)] = bf1(acc[p]); }
        } else if (wave == 6 && bi + 1 < SCAN_NC) { SCAN_G(set ^ 1); }
        SCAN_BAR();
        if (bi >= 0 && wave < 4) {
            const int vb = wave >> 1, kb = wave & 1; const float pc = PC_(set)[32 * kb + l31];
            f32x16 acc = {};
#pragma unroll
            for (int s = 0; s < 2; ++s) { const int swr = ((l31 >> 4) & 1) << 3; const sbf16x8 A = *(const LAS sbf16x8*)(UVT_(set) + (32 * vb + l31) * 40 + ((16 * s + 8 * hh) ^ (swr | (vb << 4)))), B = *(const LAS sbf16x8*)(ZT_(set) + (32 * kb + l31) * 40 + ((16 * s + 8 * hh) ^ (swr | (kb << 4))));
                acc = __builtin_amdgcn_mfma_f32_32x32x16_bf16(A, B, acc, 0, 0, 0); }
            acc = S * pc + acc; S = acc;
#pragma unroll
            for (int r = 0; r < 16; ++r) { const int v = 32 * vb + (r & 3) + 8 * (r >> 2) + 4 * hh; SBs[v * 72 + 32 * kb + l31] = bf1(acc[r]); }
        } else for (int dy_ = 0; dy_ < DUP_Y; ++dy_) if (bi >= 0 && wave < 6) {
            f32x16 acc = {};
#pragma unroll
            for (int s = 0; s < 2; ++s) { const int swr = (((l31 >> 4) & 1) | ((wave - 4) << 1)) << 3; const sbf16x8 A = *(const LAS sbf16x8*)(AM_(set) + l31 * 40 + 16 * s + 8 * hh), B = *(const LAS sbf16x8*)(UVT_(set) + (32 * (wave - 4) + l31) * 40 + ((16 * s + 8 * hh) ^ swr));
                acc = __builtin_amdgcn_mfma_f32_32x32x16_bf16(A, B, acc, 0, 0, 0); }
            float hv_[8];
#pragma unroll
            for (int r = 0; r < 8; ++r) { const int t = (r & 3) + 8 * (r >> 2) + 4 * hh; hv_[r] = Hm[(16 + t) * 65 + 32 * (wave - 4) + l31]; }
#pragma unroll
            for (int r = 0; r < 8; ++r) { const int t = (r & 3) + 8 * (r >> 2) + 4 * hh; const int v = 32 * (wave - 4) + l31; YO[t * 64 + v] = acc[r] + hv_[r]; }
        }
        SCAN_BAR();
    }
    {
        const f32x2 yv = *(const LAS f32x2*)(YO + lt * 64 + lc);
        float sm = yv.x + yv.y; sm = asum32(sm);
        const float mean = sm * (1.0f / 64.0f), d0 = yv.x - mean, d1 = yv.y - mean;
        float vr = d0 * d0 + d1 * d1; vr = asum32(vr);
        const float rstd = rsqrtf(vr * (1.0f / 64.0f) + GN_EPS);
        const unsigned tok = (unsigned)b * SEQ + (SCAN_NC - 1) * SCAN_TB + lt;
        const float o0 = (d0 * rstd * gw0 + gb0 + qb0 * bflo(qv0)) * bflo(qg0), o1 = (d1 * rstd * gw1 + gb1 + qb0 * bfhi(qv0)) * bfhi(qg0);
        *(unsigned*)(ws + (unsigned)(WS_YCAT + 2u * (tok * 2048u + 1024u + 64u * h + lc))) = pk2(o0, o1);
    }
    LDS_WAIT(); __syncthreads();
#undef SCAN_BAR
#undef SCAN_LOAD
#undef SCAN_IMG
#undef SCAN_G
#undef LOW2
#undef HIGH2
#undef GM_
#undef XB_
#undef YB_
#undef ZT_
#undef UVT_
#undef AM_
#undef PC_
#undef VF_
}

__device__ __forceinline__ void conv_fix_phase(const float* ffn_conv, unsigned char* ws, int tid, int bid_, int nwg_) {
    const bf16* HALO = (const bf16*)(ws + WS_HALO); bf16* ACT = (bf16*)(ws + WS_ACT);
    const int gt = bid_ * NTHREADS + tid, NGT = nwg_ * NTHREADS;
    constexpr int NG = DFF / 8, NT = (M / 64) * NG;
    for (int task = gt; task < NT; task += 2 * NGT) {
        v4u hw[2][8];
        const int task1 = task + NGT; const bool two = task1 < NT;
#pragma unroll
        for (int q = 0; q < 2; ++q) { const int tk = q ? (two ? task1 : task) : task;
            const int g8 = tk % NG, sg = tk / NG, ch = g8 * 8, gcol = 256 * (ch >> 7) + (ch & 127);
            const bf16* hc = HALO + (size_t)sg * 4 * NUP + gcol; const bf16* hp = ((sg * 64) & (SEQ - 1)) ? hc - 4 * NUP : hc;
            hw[q][0] = *(const v4u*)(hp + 2 * NUP); hw[q][1] = *(const v4u*)(hp + 2 * NUP + 128); hw[q][2] = *(const v4u*)(hp + 3 * NUP); hw[q][3] = *(const v4u*)(hp + 3 * NUP + 128);
            hw[q][4] = *(const v4u*)(hc); hw[q][5] = *(const v4u*)(hc + 128); hw[q][6] = *(const v4u*)(hc + NUP); hw[q][7] = *(const v4u*)(hc + NUP + 128); }
#pragma unroll
        for (int q = 0; q < 2; ++q) { if (q == 1 && !two) break; const int tk = q ? task1 : task;
            const int g8 = tk % NG, sg = tk / NG, t0 = sg * 64, ch = g8 * 8;
            float g[4][8], v[4][8];
            unpack8(hw[q][4], g[2]); unpack8(hw[q][5], v[2]); unpack8(hw[q][6], g[3]); unpack8(hw[q][7], v[3]);
            if ((t0 & (SEQ - 1)) != 0) { unpack8(hw[q][0], g[0]); unpack8(hw[q][1], v[0]); unpack8(hw[q][2], g[1]); unpack8(hw[q][3], v[1]); }
            else {
#pragma unroll
                for (int e = 0; e < 8; ++e) { g[0][e] = 0.f; g[1][e] = 0.f; v[0][e] = 0.f; v[1][e] = 0.f; } }
            float o0[8], o1[8];
            float A0[8], A1[8], A2[8], B0[8], B1[8], B2[8]; ld8f(ffn_conv + ch, A0); ld8f(ffn_conv + NUP + ch, A1); ld8f(ffn_conv + 2 * NUP + ch, A2); ld8f(ffn_conv + DFF + ch, B0); ld8f(ffn_conv + NUP + DFF + ch, B1); ld8f(ffn_conv + 2 * NUP + DFF + ch, B2);
#pragma unroll
            for (int e = 0; e < 8; ++e) { const float a0 = A0[e], a1 = A1[e], a2 = A2[e], b0 = B0[e], b1 = B1[e], b2 = B2[e];
                const float cg0 = a0 * g[0][e] + a1 * g[1][e] + a2 * g[2][e], cv0 = b0 * v[0][e] + b1 * v[1][e] + b2 * v[2][e];
                const float cg1 = a0 * g[1][e] + a1 * g[2][e] + a2 * g[3][e], cv1 = b0 * v[1][e] + b1 * v[2][e] + b2 * v[3][e];
                o0[e] = cg0 * sigm(cg0) * cv0; o1[e] = cg1 * sigm(cg1) * cv1; }
            *(v4u*)(ACT + (size_t)t0 * DFF + ch) = pack8(o0); *(v4u*)(ACT + (size_t)(t0 + 1) * DFF + ch) = pack8(o1);
        }
    }
}
__device__ __forceinline__ void conv_fix2_task(const float* conv_w, unsigned char* ws, int sg, int ch) {
    const bf16* HALO = (const bf16*)(ws + WS_HALO2); bf16* CV = (bf16*)(ws + WS_CV);
    const int t0 = sg * 64;
    float c[4][8];
    const bf16* hc = HALO + (size_t)sg * 4 * DM + ch;
    unpack8(*(const v4u*)(hc), c[2]); unpack8(*(const v4u*)(hc + DM), c[3]);
    if ((t0 & (SEQ - 1)) != 0) { unpack8(*(const v4u*)(hc - 2 * DM), c[0]); unpack8(*(const v4u*)(hc - DM), c[1]); }
    else {
#pragma unroll
        for (int e = 0; e < 8; ++e) { c[0][e] = 0.f; c[1][e] = 0.f; } }
    float o0[8], o1[8];
    float A0[8], A1[8], A2[8]; ld8f(conv_w + ch, A0); ld8f(conv_w + DM + ch, A1); ld8f(conv_w + 2 * DM + ch, A2);
#pragma unroll
    for (int e = 0; e < 8; ++e) { const float a0 = A0[e], a1 = A1[e], a2 = A2[e];
        o0[e] = a0 * c[0][e] + a1 * c[1][e] + a2 * c[2][e]; o1[e] = a0 * c[1][e] + a1 * c[2][e] + a2 * c[3][e]; }
    *(v4u*)(CV + (size_t)t0 * pg8::CV_PITCH + ch) = pack8(o0); *(v4u*)(CV + (size_t)(t0 + 1) * pg8::CV_PITCH + ch) = pack8(o1);
}
__device__ __forceinline__ void conv_mix_phase(const float* conv_w, unsigned char* ws, int tid, int bid_, int nwg_) {
    const bf16* H = (const bf16*)(ws + WS_H); bf16* MB = (bf16*)(ws + WS_MB);
    const int gt = bid_ * NTHREADS + tid, NGT = nwg_ * NTHREADS;
    constexpr int RUN = 32, NG = DM / 8;
    for (int task = gt; task < (M / RUN) * NG; task += NGT) {
        const int g8 = task % NG, t0 = (task / NG) * RUN, ch = g8 * 8;
        float w[3][8];
#pragma unroll
        for (int j = 0; j < 3; ++j)
#pragma unroll
            for (int e = 0; e < 8; ++e) w[j][e] = conv_w[j * DM + ch + e];
        float c1[8], c2[8];
#pragma unroll
        for (int e = 0; e < 8; ++e) { c1[e] = 0.f; c2[e] = 0.f; }
        const bf16* hp = H + (size_t)t0 * 6144 + ch;
        if ((t0 & (SEQ - 1)) != 0) { float a[8], u[8]; unpack8(*(const v4u*)(hp - 6144 + 2048), a); unpack8(*(const v4u*)(hp - 6144 + 4096), u);
#pragma unroll
            for (int e = 0; e < 8; ++e) c1[e] = a[e] * u[e];
            unpack8(*(const v4u*)(hp - 2 * 6144 + 2048), a); unpack8(*(const v4u*)(hp - 2 * 6144 + 4096), u);
#pragma unroll
            for (int e = 0; e < 8; ++e) c2[e] = a[e] * u[e]; }
        for (int r = 0; r < RUN; ++r) {
            float gb[8], a[8], u[8], o[8]; const bf16* q = hp + (size_t)r * 6144;
            unpack8(*(const v4u*)q, gb); unpack8(*(const v4u*)(q + 2048), a); unpack8(*(const v4u*)(q + 4096), u);
#pragma unroll
            for (int e = 0; e < 8; ++e) { const float c0 = a[e] * u[e]; o[e] = gb[e] * (w[0][e] * c2[e] + w[1][e] * c1[e] + w[2][e] * c0); c2[e] = c1[e]; c1[e] = c0; }
            *(v4u*)(MB + (size_t)(t0 + r) * DM + ch) = pack8(o);
        }
    }
}

__global__ void __launch_bounds__(NTHREADS, 2) mk_fwd(Args args) {
    extern __shared__ __attribute__((aligned(16))) unsigned char lds_raw[];
    LAS unsigned char* lds = (LAS unsigned char*)lds_raw;
    volatile LAS unsigned* MISC = (volatile LAS unsigned*)(lds + MISC_OFF);
    const int tid0 = threadIdx.x, wave0 = __builtin_amdgcn_readfirstlane(tid0 >> 6);
    unsigned char* ws = args.ws;
    gu32* ctl = (gu32*)(ws + WS_CTL);
    for (int u = tid0; u < 64; u += NTHREADS) MISC[u] = 0u;
    __syncthreads();
    XcdBarrier bar = xcd_barrier_post((unsigned*)ctl + CW_BAR, MISC + 8);
    const int lo = args.ph_lo, hi = args.ph_hi;
#define IN(k) (lo <= (k) && (k) < hi)
#define SEAM(k) do { if ((k) + 1 < hi) { for (int rb_ = 0; rb_ < REP_BAR; ++rb_) xcd_barrier(bar); } } while (0)
    bf16* XB = (bf16*)(ws + WS_XB);
    float* RS = (float*)(ws + WS_RS);

#ifndef DUP_ATT
#define DUP_ATT 1
#endif
#ifndef REP_UP
#define REP_UP 1
#endif
#ifndef REP_CS
#define REP_CS 1
#endif
#ifndef REP_AS
#define REP_AS 1
#endif
#ifndef REP_CV
#define REP_CV 1
#endif
#ifndef REP_PR
#define REP_PR 1
#endif
#ifndef REP_LO
#define REP_LO 1
#endif
#ifndef REP_DN
#define REP_DN 1
#endif
#ifndef REP_MO
#define REP_MO 1
#endif
#ifndef REP_GB
#define REP_GB 1
#endif
#ifndef REP_MX
#define REP_MX 1
#endif
#ifndef REP_BAR
#define REP_BAR 1
#endif
#ifndef MK_PHASES
#define MK_PHASES 0xfff
#endif
#define PH_ON(k) (((MK_PHASES) >> (k)) & 1)
#define LB(l) ((l) == 0 ? 1 : (l) == 1 ? 21 : (l) == 2 ? 29 : 51)
#define FO(l) (((l) & 1) ? 4 : ((l) == 0 ? 16 : 18))
#define OO(l) (((l) & 1) ? 3 : 15)
    for (int li = 0; li < 4; ++li) {
        const bool even = (li & 1) == 0;
        const int pb = 1 + PH_PER_LAYER * li, lb = LB(li);
        unsigned char* wsw = ws + (even ? (size_t)0 : WB_ODD);
#if PH_ON(9)
        if (li == 0 && IN(0)) { const int wave = opq_s(wave0), bid = opq_s((int)blockIdx.x), nwg = opq_s((int)gridDim.x); (void)bid; (void)nwg;
            const int lane = lane_id_opaque(), tid = wave * 64 + lane;
            prologue_rows(args.in[0], XB, RS, wave, lane, bid, nwg);
            const ConvP C{args.in[1], args.in[2], args.in[16], args.in[17], args.in[18], args.in[20], args.in[7], args.in[9], args.in[10], nullptr, args.in[8], nullptr};
            convert_layer(C, 0, ws, lds, wave, lane, tid, bid, nwg, bid, 32 * (NPROJ / 128), nwg, true);
            SEAM(0);
        }
#endif
#if PH_ON(0)
        if (IN(pb + 0)) { const int wave = opq_s(wave0), bid = opq_s((int)blockIdx.x), nwg = opq_s((int)gridDim.x); (void)bid; (void)nwg;
            if (even) {
                pg8::Gemm g{XB, (const bf16*)(wsw + WS_WMIX), M, NPROJ, DM}; pg8::StaticOrder S; S.init(M, NPROJ, nwg, bid);
                pg8::EpiProj E{(bf16*)(ws + WS_R0), li == 0 ? 6432 : 6464, RS + (size_t)(2 * li) * M * 8, args.in[lb + 2], args.in[lb + 3], (bf16*)(ws + WS_QN), (bf16*)(ws + WS_KN), (bf16*)(ws + WS_VV), (float*)(ws + WS_KMEAN),
                               (LAS float*)(lds + XCH_OFF), (LAS float*)(lds + MISC_OFF + 1024)};
                for (int rep = 0; rep < REP_MX; ++rep)
                pg8::gemm_phase<pg8::EpiProj, pg8::StaticOrder, true, true>(lds, g, S, E, wave);
                const bool half_ = (nwg == 256);
                if (!half_ || bid >= 128) {
                    const int fo = FO(li);
                    const ConvP C{args.in[lb], args.in[lb + 1], args.in[lb + OO(li)], args.in[lb + fo], args.in[lb + fo + 1], args.in[lb + fo + 3], nullptr, nullptr, nullptr, nullptr, nullptr, nullptr};
                    const int lane_ = lane_id_opaque();
                    convert_layer(C, li, ws, lds, wave, lane_, wave * 64 + lane_, bid, nwg, 32 * (NPROJ / 128) + (half_ ? bid - 128 : bid), 0x7fffffff, half_ ? 128 : nwg, false);
                }
            } else {
                pg8::Gemm g{XB, (const bf16*)(wsw + WS_WMIX), M, 4096, DM}; pg8::StaticOrder S; S.init(M, 4096, nwg, bid);
                pg8::EpiCU E{(bf16*)(ws + WS_CV), (bf16*)(ws + WS_HALO2), RS + (size_t)(2 * li) * M * 8, (LAS float*)(lds + MISC_OFF + 1024), args.in[lb + 2], (LAS float*)(lds + TAP_OFF)};
                for (int rep = 0; rep < REP_MO; ++rep)
                pg8::gemm_phase<pg8::EpiCU, pg8::StaticOrder, true, true>(lds, g, S, E, wave);
            }
            SEAM(pb + 0);
        }
#endif
#if PH_ON(1)
        if (even && IN(pb + 1)) { const int wave = opq_s(wave0), bid = opq_s((int)blockIdx.x), nwg = opq_s((int)gridDim.x); (void)bid; (void)nwg;
            const int lane = lane_id_opaque(), tid = wave * 64 + lane;
            for (int rep = 0; rep < REP_PR; ++rep)
            prep_phase(args.in[lb + 2], args.in[lb + 3], args.in[lb + 4], li != 0, ws, lds, wave, lane, tid, bid, nwg);
            SEAM(pb + 1);
        }
#endif
#if PH_ON(2)
        if (even && IN(pb + 2)) { const int wave = opq_s(wave0), bid = opq_s((int)blockIdx.x), nwg = opq_s((int)gridDim.x); (void)bid; (void)nwg;
            pg8::Gemm g{(const bf16*)(ws + WS_ZACT), (const bf16*)(ws + WS_WLORA), M, NLORA, KLORA}; pg8::StaticOrder S; S.init(M, NLORA, nwg, bid);
            pg8::EpiLora E{(const bf16*)(ws + WS_PROJ), args.in[lb + 4], args.in[lb + 5], args.in[lb + 7], li == 0 ? (const float*)nullptr : args.in[45], args.in[lb + 10], args.in[lb + 11], args.in[lb + 12], (bf16*)(ws + WS_VFIRST),
                           (unsigned*)(ws + WS_P0), (unsigned*)(ws + WS_P1), (unsigned*)(ws + WS_P2), (unsigned*)(ws + WS_P3), (float*)(ws + WS_PCH), (float*)(ws + WS_BON), (LAS float*)(lds + XCH_OFF)};
            for (int rep = 0; rep < REP_LO; ++rep) { if (rep > 0) xcd_barrier(bar);
            pg8::gemm_phase<pg8::EpiLora, pg8::StaticOrder, true, true>(lds, g, S, E, wave); }
            SEAM(pb + 2);
        }
#endif
#if PH_ON(2)
        if (!even && IN(pb + 2)) { const int wave = opq_s(wave0), bid = opq_s((int)blockIdx.x), nwg = opq_s((int)gridDim.x); (void)bid; (void)nwg;
            pg8::Gemm g{XB, (const bf16*)(wsw + WS_WMIX) + (size_t)4096 * DM, M, DM, DM}; pg8::StaticOrder S; S.init(M, DM, nwg, bid);
            pg8::EpiGateB E{(bf16*)(ws + WS_MB), (const bf16*)(ws + WS_CV), RS + (size_t)(2 * li) * M * 8, (LAS float*)(lds + MISC_OFF + 1024)};
            {
                const int tid_ = wave * 64 + lane_id_opaque();
                pg8::StaticOrder S2; S2.init(M, DM, nwg, bid); pg8::Unit u_;
                const int i_ = opq_s(wave >> 1);
                if (S2.next(i_, u_)) conv_fix2_task(args.in[lb + 2], ws, u_.pm * 4 + ((tid_ >> 5) & 3), u_.pn * 256 + (tid_ & 31) * 8);
                for (int j_ = i_ + 4; nwg < 128 && S2.next(j_, u_); j_ += 4) conv_fix2_task(args.in[lb + 2], ws, u_.pm * 4 + ((tid_ >> 5) & 3), u_.pn * 256 + (tid_ & 31) * 8);
                asm volatile("s_waitcnt vmcnt(0)" ::: "memory");
            }
            for (int rep = 0; rep < REP_GB; ++rep)
            pg8::gemm_phase<pg8::EpiGateB, pg8::StaticOrder, true, true>(lds, g, S, E, wave);
            SEAM(pb + 2);
        }
#endif
#if PH_ON(3)
        if (even && IN(pb + 3)) { const int wave = opq_s(wave0), bid = opq_s((int)blockIdx.x), nwg = opq_s((int)gridDim.x); (void)bid; (void)nwg;
            for (int rep = 0; rep < REP_AS; ++rep) {
            if (rep > 0) xcd_barrier(bar);
            gu32* qctr = ctl + CW_QUEUE + 64 * (li + 4 * rep);
#ifdef EXP_STATIC
            for (int item = 128 + (int)blockIdx.x; item < 640; item += (int)gridDim.x) {
#else
            for (;;) {
                if (threadIdx.x == 0) MISC[12] = __hip_atomic_fetch_add(qctr, 1u, RLX_AGENT);
                __syncthreads();
                const int item = (int)MISC[12];
                __syncthreads();
                if (item >= 640 + 448) break;
                if (item >= 640) {
                    const int ln = li + 1, nb = LB(ln), fo = FO(ln), cb = item - 640;
                    const ConvP C{args.in[nb], args.in[nb + 1], args.in[nb + OO(ln)], args.in[nb + fo], args.in[nb + fo + 1], args.in[nb + fo + 3], nullptr, nullptr, nullptr, nullptr, nullptr, nullptr};
                    const int lane_ = lane_id_opaque();
                    convert_layer(C, ln, ws, lds, wave, lane_, wave * 64 + lane_, bid, nwg, 14 * cb, 14 * cb + 14, 1, false);
                    continue;
                }
#endif
                if (item < 128) {
#if PH_ON(10)
#if defined(SCAN_CHK) && SCAN_CHK == 5
                    scan_chain_seq(item >> 4, item & 15, args.in[lb + 12], args.in[lb + 13], args.in[lb + 14], ws, lds, wave);
                    __syncthreads();
#endif
                    scan_chain(item >> 4, item & 15, args.in[lb + 12], args.in[lb + 13], args.in[lb + 14], ws, lds, wave);
#endif
                } else {
#if PH_ON(11)
                    const int j = item - 128, blk = 7 - (j >> 6), bh = j & 63, b = bh >> 3, h = bh & 7;
                    const size_t hb = ((size_t)b * 8 + h) * SEQ * 128;
                    attn::BlockRef cur;
                    cur.Q = (const bf16*)(ws + WS_QN) + hb + (size_t)blk * 256 * 128; cur.K = (const bf16*)(ws + WS_KN) + hb; cur.V = (const bf16*)(ws + WS_VV) + hb;
                    cur.O = (bf16*)(ws + WS_YCAT) + ((size_t)b * SEQ + blk * 256) * 2048 + h * 128; cur.P0 = blk * 256;
                    for (int da_ = 0; da_ < DUP_ATT; ++da_) {
                    attn::Seam Sm;
                    attn::moba_prime(cur, (char*)lds_raw, Sm, wave);
                    const float slope = exp2f(-(float)(h + 1));
                    attn::moba_block(cur, cur, (char*)lds_raw, Sm, blk, slope * (1.0f / attn::SCALE), (const float*)(ws + WS_KMEAN) + ((size_t)b * 8 + h) * 1024, wave);
                    }
#endif
                }
            }
            }
            SEAM(pb + 3);
        }
#endif
#if PH_ON(4)
        if (IN(pb + 4)) { const int wave = opq_s(wave0), bid = opq_s((int)blockIdx.x), nwg = opq_s((int)gridDim.x); (void)bid; (void)nwg;
            pg8::Gemm g{even ? (const bf16*)(ws + WS_YCAT) : (const bf16*)(ws + WS_MB), (const bf16*)(wsw + WS_WOUT), M, DM, DM}; pg8::StaticOrder S; S.init(M, DM, nwg, bid);
            pg8::EpiResid E{nullptr, XB, RS + (size_t)(2 * li + 1) * M * 8, (LAS float*)(lds + XCH_OFF)};
            pg8::gemm_phase<pg8::EpiResid, pg8::StaticOrder, true, true>(lds, g, S, E, wave);
            SEAM(pb + 4);
        }
#endif
#if PH_ON(5)
        if (IN(pb + 5)) { const int wave = opq_s(wave0), bid = opq_s((int)blockIdx.x), nwg = opq_s((int)gridDim.x); (void)bid; (void)nwg;
            pg8::Gemm g{XB, (const bf16*)(wsw + WS_WUP), M, NUP, DM}; pg8::StaticOrder S; S.init(M, NUP, nwg, bid);
            pg8::EpiUpConv E{(bf16*)(ws + WS_ACT), (bf16*)(ws + WS_HALO), RS + (size_t)(2 * li + 1) * M * 8, (LAS float*)(lds + MISC_OFF + 1024), args.in[lb + FO(li) + 2], (LAS float*)(lds + TAP_OFF)};
            for (int rep = 0; rep < REP_UP; ++rep)
            pg8::gemm_phase<pg8::EpiUpConv, pg8::StaticOrder, true, true>(lds, g, S, E, wave);
            SEAM(pb + 5);
        }
#endif
#if PH_ON(6)
        if (IN(pb + 6)) { const int wave = opq_s(wave0), bid = opq_s((int)blockIdx.x), nwg = opq_s((int)gridDim.x); (void)bid; (void)nwg; const int tid = wave * 64 + lane_id_opaque(); for (int rep = 0; rep < REP_CS; ++rep) conv_fix_phase(args.in[lb + FO(li) + 2], ws, tid, bid, nwg);
            if (li == 1) {
                const int nb2 = LB(2), fo2 = FO(2);
                const ConvP C2{args.in[nb2], args.in[nb2 + 1], args.in[nb2 + OO(2)], args.in[nb2 + fo2], args.in[nb2 + fo2 + 1], args.in[nb2 + fo2 + 3], args.in[35], args.in[37], args.in[38], args.in[46], args.in[36], args.in[45]};
                const int lane2 = lane_id_opaque();
                __syncthreads();
                convert_layer(C2, 2, ws, lds, wave, lane2, wave * 64 + lane2, bid, nwg, bid, 32 * (NPROJ / 128), nwg, true);
            }
            SEAM(pb + 6); }
#endif
#if PH_ON(7)
        if (IN(pb + 7)) { const int wave = opq_s(wave0), bid = opq_s((int)blockIdx.x), nwg = opq_s((int)gridDim.x); (void)bid; (void)nwg;
            pg8::Gemm g{(const bf16*)(ws + WS_ACT), (const bf16*)(wsw + WS_WDN), M, DM, DFF}; pg8::StaticOrder S; S.init(M, DM, nwg, bid);
            pg8::EpiResid E{li == 3 ? args.out : (float*)nullptr, XB, RS + (size_t)(2 * li + 2) * M * 8, (LAS float*)(lds + XCH_OFF)};
            pg8::gemm_phase<pg8::EpiResid, pg8::StaticOrder, true, true>(lds, g, S, E, wave);
            SEAM(pb + 7);
        }
#endif
#if PH_ON(8)
        if (false) {   const int wave = opq_s(wave0), bid = opq_s((int)blockIdx.x), nwg = opq_s((int)gridDim.x); (void)bid; (void)nwg;
            const int ln = li + 1;
            const int nb = LB(ln), fo = FO(ln);
            const ConvP C{args.in[nb], args.in[nb + 1], args.in[nb + OO(ln)], args.in[nb + fo], args.in[nb + fo + 1], args.in[nb + fo + 3],
                          ln == 2 ? args.in[35] : nullptr, ln == 2 ? args.in[37] : nullptr, ln == 2 ? args.in[38] : nullptr, ln == 2 ? args.in[46] : nullptr, ln == 2 ? args.in[36] : nullptr, ln == 2 ? args.in[45] : nullptr};
            const int lane = lane_id_opaque(), tid = wave * 64 + lane;
            convert_layer(C, ln, ws, lds, wave, lane, tid, bid, nwg, bid, 32 * (NPROJ / 128), nwg, true);
#if REP_CV > 1
            __syncthreads();
            convert_layer(C, ln, ws, lds, wave, lane_id_opaque(), wave * 64 + lane_id_opaque(), bid, nwg, bid, 32 * (NPROJ / 128), nwg, true);
#endif
            SEAM(pb + 8);
        }
#endif
    }
#ifdef SCAN_CHK
    {
        xcd_barrier(bar);
        float e = __uint_as_float(__hip_atomic_load(ctl + CW_DBG, RLX_AGENT));
        { const float l2_ = __uint_as_float(__hip_atomic_load(ctl + CW_DBG + 64, RLX_AGENT)); if (l2_ > 0.f) e = l2_; }
        float* o = args.out; const size_t n = (size_t)M * DM;
        for (size_t i = (size_t)blockIdx.x * NTHREADS + threadIdx.x; i < n; i += (size_t)gridDim.x * NTHREADS) o[i] *= (1.0f + 100.0f * e);
    }
#endif
#undef IN
#undef SEAM
}

#ifdef PROBE_OFF
__global__ void mk_probe(const unsigned short* src, int ld, int coloff, float* out) {
    const size_t n = (size_t)M * DM;
    for (size_t i = (size_t)blockIdx.x * blockDim.x + threadIdx.x; i < n; i += (size_t)gridDim.x * blockDim.x) {
        const size_t r = i / DM, c = (i % DM) % PROBE_NC; float v_ = __uint_as_float(((unsigned)src[r * ld + coloff + c]) << 16); out[i] = (v_ - v_ == 0.f) ? v_ : 1000.0f; }
}
#endif
#ifndef MK_N_LAUNCHES
#define MK_N_LAUNCHES 1
#endif
extern "C" void kernel_launch(void* const* d_in, const int* in_sizes, int n_in, void* d_out, int out_size, void* d_ws, size_t ws_size, hipStream_t stream) {
    static int grid = 0;
    if (grid == 0) {
        if (n_in != N_IN || in_sizes[0] != M * DM || out_size != M * DM || ws_size < WS_END) {
            fprintf(stderr, "kernel_launch: built for %d inputs, x/out of %d floats, >= %zu bytes of workspace; got n_in %d, in0 %d, out %d, ws %zu; nothing launched\n", N_IN, M * DM, (size_t)WS_END, n_in, n_in > 0 ? in_sizes[0] : -1, out_size, ws_size);
            grid = -1; return; }
        int dev = 0, cus = 0, per_cu = 0;
        if (hipGetDevice(&dev) != hipSuccess || hipDeviceGetAttribute(&cus, hipDeviceAttributeMultiprocessorCount, dev) != hipSuccess) { grid = -1; return; }
        if (hipFuncSetAttribute((const void*)mk_fwd, hipFuncAttributeMaxDynamicSharedMemorySize, LDS_BYTES) != hipSuccess) { fprintf(stderr, "kernel_launch: hipFuncSetAttribute failed\n"); grid = -1; return; }
        if (hipOccupancyMaxActiveBlocksPerMultiprocessor(&per_cu, (const void*)mk_fwd, NTHREADS, LDS_BYTES) != hipSuccess || per_cu < 1)
            fprintf(stderr, "kernel_launch: note: occupancy query reports %d workgroups per CU\n", per_cu);
        (void)hipGetLastError();
        grid = cus;
    }
    if (grid < 0) return;
    if (hipMemsetAsync((char*)d_ws + WS_CTL, 0, CTL_ZERO_BYTES, stream) != hipSuccess) { fprintf(stderr, "kernel_launch: hipMemsetAsync failed\n"); return; }
    Args a{};
    for (int i = 0; i < N_IN; ++i) a.in[i] = (const float*)d_in[i];
    a.out = (float*)d_out; a.ws = (unsigned char*)d_ws;
#if MK_N_LAUNCHES == 1
    a.ph_lo = 0; a.ph_hi = N_PHASES;
    hipLaunchKernelGGL(mk_fwd, dim3(grid), dim3(NTHREADS), LDS_BYTES, stream, a);
#else
#ifndef PROBE_LAST
#define PROBE_LAST (N_PHASES - 1)
#endif
    for (int p = 0; p <= PROBE_LAST; ++p) { a.ph_lo = p; a.ph_hi = p + 1; hipLaunchKernelGGL(mk_fwd, dim3(grid), dim3(NTHREADS), LDS_BYTES, stream, a); }
#ifdef PROBE_OFF
    hipLaunchKernelGGL(mk_probe, dim3(2048), dim3(256), 0, stream, (const unsigned short*)((const unsigned char*)d_ws + (size_t)(PROBE_OFF)), (int)(PROBE_LD), (int)(PROBE_COL), (float*)d_out);
#endif
#endif
    const hipError_t le = hipPeekAtLastError();
    if (le != hipSuccess) fprintf(stderr, "kernel_launch: launch failed: %s\n", hipGetErrorName(le));
}
```
